# Optimizing an MI355X kernel written in HIP

```python
import math
import jax, jax.numpy as jnp
from jax import lax
import numpy as np

D_MODEL = 1024
BATCH = 4
SEQ = 4096
DEPTH = 4

N_MIXERS = 2
N_A_LAYERS = (DEPTH + 1) // 2
N_B_LAYERS = DEPTH // 2

S5_GROUP = 16
S5_GROUPS = D_MODEL // S5_GROUP
S5_STATE = 64
S5_DT_MIN = 0.001
S5_DT_MAX = 0.1
N_DIRS = 2

DIL_GROUPS = ((128, 1), (512, 4), (2048, 16))
N_DIL = len(DIL_GROUPS)
HEADS_PER_GROUP = 8
HEAD_DIM = D_MODEL // HEADS_PER_GROUP
ATT_WIDTH = N_DIL * HEADS_PER_GROUP * HEAD_DIM

N_BUCKETS = 32
MAX_DISTANCE = 1024
N_BIAS_HEADS = N_DIL * HEADS_PER_GROUP

MEM_LEN = 256
MEM_HEADS = 4
MEM_HEAD_DIM = D_MODEL // MEM_HEADS

D_FF = 4 * D_MODEL
EPS = 1e-6
NEG_INF = -1e30

kernel_name = "hybrid_s5_dilated_attn_encoder"


def rms_norm(x, g):
    xf = x.astype(jnp.float32)
    y = xf * lax.rsqrt(jnp.mean(xf * xf, axis=-1, keepdims=True) + EPS)
    return (y * g.astype(jnp.float32)).astype(x.dtype)


def t5_bucket(rel):
    nb = N_BUCKETS // 2
    ret = (rel > 0).astype(np.int32) * nb
    n = np.abs(rel)
    max_exact = nb // 2
    large = max_exact + (np.log(np.maximum(n, 1).astype(np.float32) / max_exact)
                         / np.log(MAX_DISTANCE / max_exact) * (nb - max_exact)).astype(np.int32)
    large = np.minimum(large, nb - 1)
    return (ret + np.where(n < max_exact, n, large)).astype(np.int32)


def complex_mul(ar, ai, br, bi):
    return ar * br - ai * bi, ar * bi + ai * br


def s5_direction(u, lam_re, lam_im, log_dt, b_re, b_im, c_re, c_im, reverse):
    f32 = jnp.float32
    lam_re = lam_re.astype(f32); lam_im = lam_im.astype(f32)
    b_re = b_re.astype(f32); b_im = b_im.astype(f32)
    c_re = c_re.astype(f32); c_im = c_im.astype(f32)
    dt = jnp.exp(log_dt.astype(f32))[:, None]
    mag = jnp.exp(lam_re * dt)
    ang = lam_im * dt
    abar_re = mag * jnp.cos(ang)
    abar_im = mag * jnp.sin(ang)
    nr = abar_re - 1.0
    ni = abar_im
    den = lam_re * lam_re + lam_im * lam_im
    f_re = (nr * lam_re + ni * lam_im) / den
    f_im = (ni * lam_re - nr * lam_im) / den
    bbar_re, bbar_im = complex_mul(f_re[..., None], f_im[..., None], b_re, b_im)
    bu_re = jnp.einsum('bsgc,gpc->bsgp', u, bbar_re)
    bu_im = jnp.einsum('bsgc,gpc->bsgp', u, bbar_im)
    seq = u.shape[1]
    a_re = jnp.broadcast_to(abar_re, (1, seq) + abar_re.shape)
    a_im = jnp.broadcast_to(abar_im, (1, seq) + abar_im.shape)

    def combine(left, right):
        a1r, a1i, b1r, b1i = left
        a2r, a2i, b2r, b2i = right
        ar, ai = complex_mul(a2r, a2i, a1r, a1i)
        br, bi = complex_mul(a2r, a2i, b1r, b1i)
        return ar, ai, br + b2r, bi + b2i

    _, _, xr, xi = lax.associative_scan(combine, (a_re, a_im, bu_re, bu_im),
                                        reverse=reverse, axis=1)
    return jnp.einsum('bsgp,gcp->bsgc', xr, c_re) - jnp.einsum('bsgp,gcp->bsgc', xi, c_im)


def s5_mixer(h, lam_re, lam_im, log_dt, b_re, b_im, c_re, c_im, d_skip, w_glu):
    bsz, seq, _ = h.shape
    u = h.astype(jnp.float32).reshape(bsz, seq, S5_GROUPS, S5_GROUP)
    y = d_skip.astype(jnp.float32).reshape(S5_GROUPS, S5_GROUP) * u
    for di, rev in enumerate((False, True)):
        y = y + s5_direction(u, lam_re[di], lam_im[di], log_dt[di], b_re[di], b_im[di],
                             c_re[di], c_im[di], rev)
    g = jax.nn.gelu(y.reshape(bsz, seq, D_MODEL)).astype(h.dtype)
    a, b = jnp.split(g @ w_glu, 2, axis=-1)
    return a * jax.nn.sigmoid(b)


def dilated_branch(q, k, v, bias_g, window, dil):
    bsz, seq, nh, e = q.shape
    half = window // (2 * dil)
    blk = half
    sub_len = seq // dil
    nb = -(-sub_len // blk)
    lp = nb * blk

    def to_sub(t):
        return t.reshape(bsz, sub_len, dil, nh, e).transpose(0, 2, 3, 1, 4)

    qs, ks, vs = to_sub(q), to_sub(k), to_sub(v)
    qb = jnp.pad(qs, ((0, 0), (0, 0), (0, 0), (0, lp - sub_len), (0, 0))).reshape(bsz, dil, nh, nb, blk, e)

    def key_blocks(t):
        tp = jnp.pad(t, ((0, 0), (0, 0), (0, 0), (blk, lp - sub_len + blk), (0, 0)))
        tp = tp.reshape(bsz, dil, nh, nb + 2, blk, e)
        return jnp.concatenate([tp[:, :, :, :-2], tp[:, :, :, 1:-1], tp[:, :, :, 2:]], axis=4)

    kb, vb = key_blocks(ks), key_blocks(vs)

    qi = np.arange(blk)[:, None]
    kj = np.arange(3 * blk)[None, :]
    rel = kj - blk - qi
    band = np.abs(rel) <= half
    key_idx = np.arange(nb)[:, None] * blk + np.arange(3 * blk)[None, :] - blk
    key_ok = (key_idx >= 0) & (key_idx < sub_len)
    allowed = band[None] & key_ok[:, None, :]
    bucket = t5_bucket(rel * dil)
    bias = jnp.transpose(bias_g[bucket], (2, 0, 1)).astype(jnp.float32)

    logits = jnp.einsum('bdhnqe,bdhnke->bdhnqk', qb, kb).astype(jnp.float32) * (e ** -0.5)
    logits = logits + bias[None, None, :, None]
    logits = jnp.where(allowed[None, None, None], logits, NEG_INF)
    m = jnp.max(logits, axis=-1, keepdims=True)
    p = jnp.exp(logits - m)
    denom = jnp.sum(p, axis=-1, keepdims=True)
    out = jnp.einsum('bdhnqk,bdhnke->bdhnqe', p, vb.astype(jnp.float32)) / denom
    lse = (m + jnp.log(denom))[..., 0]
    out = out.reshape(bsz, dil, nh, lp, e)[:, :, :, :sub_len]
    out = out.transpose(0, 3, 1, 2, 4).reshape(bsz, seq, nh, e)
    lse = lse.reshape(bsz, dil, nh, lp)[:, :, :, :sub_len]
    lse = lse.transpose(0, 3, 1, 2).reshape(bsz, seq, nh)
    return out, lse


def dilated_attention_mixer(h, w_qkv, w_o, g_q, g_k, bias_table):
    bsz, seq, _ = h.shape
    qkv = (h @ w_qkv).reshape(bsz, seq, 3, N_DIL, HEADS_PER_GROUP, HEAD_DIM)
    q = rms_norm(qkv[:, :, 0], g_q)
    k = rms_norm(qkv[:, :, 1], g_k)
    v = qkv[:, :, 2]
    outs, lses = [], []
    for gi, (window, dil) in enumerate(DIL_GROUPS):
        bias_g = bias_table[:, gi * HEADS_PER_GROUP:(gi + 1) * HEADS_PER_GROUP]
        o, l = dilated_branch(q[:, :, gi], k[:, :, gi], v[:, :, gi], bias_g, window, dil)
        outs.append(o)
        lses.append(l)
    o = jnp.stack(outs, axis=2)
    alpha = jax.nn.softmax(jnp.stack(lses, axis=2), axis=2)
    merged = jnp.sum(alpha[..., None] * o, axis=2).reshape(bsz, seq, D_MODEL)
    return merged.astype(h.dtype) @ w_o


def memory_cross_attention(h, mem_n, w_q, w_kv, w_o, g_q, g_k):
    bsz, seq, _ = h.shape
    mlen = mem_n.shape[1]
    q = rms_norm((h @ w_q).reshape(bsz, seq, MEM_HEADS, MEM_HEAD_DIM), g_q)
    kv = (mem_n @ w_kv).reshape(bsz, mlen, 2, MEM_HEADS, MEM_HEAD_DIM)
    k = rms_norm(kv[:, :, 0], g_k)
    v = kv[:, :, 1]
    logits = jnp.einsum('bshe,bmhe->bhsm', q, k).astype(jnp.float32) * (MEM_HEAD_DIM ** -0.5)
    p = jax.nn.softmax(logits, axis=-1)
    o = jnp.einsum('bhsm,bmhe->bshe', p, v.astype(jnp.float32)).reshape(bsz, seq, D_MODEL)
    return o.astype(h.dtype) @ w_o


def sq_relu_mlp(h, w1, w2):
    return jnp.square(jax.nn.relu(h @ w1)) @ w2


def setup_inputs(seed: int = 0) -> dict:
    key = jax.random.key(seed)
    ks = jax.random.split(key, 32)
    f32 = jnp.float32
    nrm = lambda k, s, sc: jax.random.normal(k, s, f32) * sc
    gain = lambda k, s: 1.0 + 0.05 * jax.random.normal(k, s, f32)
    G, P, C = S5_GROUPS, S5_STATE, S5_GROUP
    lam_im0 = jnp.pi * jnp.arange(P, dtype=f32)
    return {
        "x": nrm(ks[0], (BATCH, SEQ, D_MODEL), 1.0),
        "mem": nrm(ks[1], (BATCH, MEM_LEN, D_MODEL), 1.0),
        "bias_table": nrm(ks[2], (N_BUCKETS, N_BIAS_HEADS), 0.2),
        "norm_mix": gain(ks[3], (DEPTH, D_MODEL)),
        "norm_xattn": gain(ks[4], (DEPTH, D_MODEL)),
        "norm_mem": gain(ks[5], (DEPTH, D_MODEL)),
        "norm_mlp": gain(ks[6], (DEPTH, D_MODEL)),
        "s5_lambda_re": -0.5 + nrm(ks[7], (N_A_LAYERS, N_DIRS, G, P), 0.01),
        "s5_lambda_im": lam_im0 + nrm(ks[8], (N_A_LAYERS, N_DIRS, G, P), 0.01),
        "s5_log_dt": jax.random.uniform(ks[9], (N_A_LAYERS, N_DIRS, G), f32,
                                        minval=math.log(S5_DT_MIN), maxval=math.log(S5_DT_MAX)),
        "s5_b_re": nrm(ks[10], (N_A_LAYERS, N_DIRS, G, P, C), (2.0 * C) ** -0.5),
        "s5_b_im": nrm(ks[11], (N_A_LAYERS, N_DIRS, G, P, C), (2.0 * C) ** -0.5),
        "s5_c_re": nrm(ks[12], (N_A_LAYERS, N_DIRS, G, C, P), (2.0 * P) ** -0.5),
        "s5_c_im": nrm(ks[13], (N_A_LAYERS, N_DIRS, G, C, P), (2.0 * P) ** -0.5),
        "s5_d": nrm(ks[14], (N_A_LAYERS, D_MODEL), 1.0),
        "s5_w_glu": nrm(ks[15], (N_A_LAYERS, D_MODEL, 2 * D_MODEL), D_MODEL ** -0.5),
        "attn_w_qkv": nrm(ks[16], (N_B_LAYERS, D_MODEL, 3 * ATT_WIDTH), D_MODEL ** -0.5),
        "attn_w_o": nrm(ks[17], (N_B_LAYERS, HEADS_PER_GROUP * HEAD_DIM, D_MODEL), D_MODEL ** -0.5),
        "attn_q_gain": gain(ks[18], (N_B_LAYERS, HEAD_DIM)),
        "attn_k_gain": gain(ks[19], (N_B_LAYERS, HEAD_DIM)),
        "xattn_w_q": nrm(ks[20], (DEPTH, D_MODEL, D_MODEL), D_MODEL ** -0.5),
        "xattn_w_kv": nrm(ks[21], (DEPTH, D_MODEL, 2 * D_MODEL), D_MODEL ** -0.5),
        "xattn_w_o": nrm(ks[22], (DEPTH, D_MODEL, D_MODEL), D_MODEL ** -0.5),
        "xattn_q_gain": gain(ks[23], (DEPTH, MEM_HEAD_DIM)),
        "xattn_k_gain": gain(ks[24], (DEPTH, MEM_HEAD_DIM)),
        "mlp_w1": nrm(ks[25], (DEPTH, D_MODEL, D_FF), D_MODEL ** -0.5),
        "mlp_w2": nrm(ks[26], (DEPTH, D_FF, D_MODEL), D_FF ** -0.5),
    }


def reference(x, mem, bias_table, norm_mix, norm_xattn, norm_mem, norm_mlp,
              s5_lambda_re, s5_lambda_im, s5_log_dt, s5_b_re, s5_b_im, s5_c_re, s5_c_im,
              s5_d, s5_w_glu, attn_w_qkv, attn_w_o, attn_q_gain, attn_k_gain,
              xattn_w_q, xattn_w_kv, xattn_w_o, xattn_q_gain, xattn_k_gain,
              mlp_w1, mlp_w2):
    h = x
    for i in range(DEPTH):
        j = i // N_MIXERS
        hn = rms_norm(h, norm_mix[i])
        if i % N_MIXERS == 0:
            mix = s5_mixer(hn, s5_lambda_re[j], s5_lambda_im[j], s5_log_dt[j],
                           s5_b_re[j], s5_b_im[j], s5_c_re[j], s5_c_im[j],
                           s5_d[j], s5_w_glu[j])
        else:
            mix = dilated_attention_mixer(hn, attn_w_qkv[j], attn_w_o[j],
                                          attn_q_gain[j], attn_k_gain[j], bias_table)
        h = h + mix
        h = h + memory_cross_attention(rms_norm(h, norm_xattn[i]), rms_norm(mem, norm_mem[i]),
                                       xattn_w_q[i], xattn_w_kv[i], xattn_w_o[i],
                                       xattn_q_gain[i], xattn_k_gain[i])
        h = h + sq_relu_mlp(rms_norm(h, norm_mlp[i]), mlp_w1[i], mlp_w2[i])
    return h
```

```cpp
#include <hip/hip_runtime.h>
#include <cstdint>
#include <cstdio>

typedef unsigned short bf16_t;
typedef unsigned u32x4 __attribute__((ext_vector_type(4)));
typedef unsigned u32x2 __attribute__((ext_vector_type(2)));
typedef float f32x4 __attribute__((ext_vector_type(4)));

constexpr int BATCH = 4, SEQ = 4096, DM = 1024, M = BATCH * SEQ, DEPTH = 4;
constexpr int MEMLEN = 256, MROWS = BATCH * MEMLEN;
constexpr int DFF = 4096;
constexpr float EPS = 1e-6f;
constexpr float LOG2E = 1.4426950408889634f;
constexpr float QSCALE_DIL = 0.08838834764831845f * LOG2E;
constexpr float QSCALE_X = 0.0625f * LOG2E;

constexpr size_t MiB = 1u << 20;
constexpr size_t WS_CTL = 0;
constexpr size_t WS_MISC = 1 * MiB;
constexpr size_t WS_SSQ = 2 * MiB;
constexpr size_t WS_HB = 4 * MiB;
constexpr size_t WS_KV = 36 * MiB;
constexpr size_t WS_MEMB = 52 * MiB;
constexpr size_t WS_T1 = 54 * MiB;
constexpr size_t WS_T2 = 86 * MiB;
constexpr size_t WS_BIG = 118 * MiB;
constexpr size_t WS_W = 246 * MiB;
constexpr size_t WS_END = 342 * MiB;

__device__ __forceinline__ float bf2f(bf16_t v) { return __uint_as_float((unsigned)v << 16); }
__device__ __forceinline__ unsigned f2bf(float f) { unsigned u = __float_as_uint(f); return (u + 0x7fffu + ((u >> 16) & 1u)) >> 16; }
__device__ __forceinline__ unsigned pk2(float lo, float hi) { return f2bf(lo) | (f2bf(hi) << 16); }

namespace pg8 {
#define PG8_LAS __attribute__((address_space(3)))
typedef short bf16x8 __attribute__((ext_vector_type(8)));
constexpr int BM = 256, BK = 64, HALF = 128, HTB = HALF * BK * 2  , STAGE_BYTES = 8 * HTB, NXCD = 8, WGM = 8;
constexpr int XCH_OFF = STAGE_BYTES;

__host__ __device__ __forceinline__ int lds_byte(int r, int c) { const int st = (r >> 4) * 2 + (c >> 5), rr = r & 15, cc = c & 31, ob = rr * 64 + cc * 2; return st * 1024 + (ob ^ (((ob >> 9) & 1) << 5)); }
__host__ __device__ __forceinline__ void stage_rc(int b, int& R, int& C) { const int st = b / 1024, sb = b % 1024, swz = sb ^ (((sb >> 9) & 1) << 5); R = (st >> 1) * 16 + swz / 64; C = (st & 1) * 32 + (swz % 64) / 2; }
__host__ __device__ __forceinline__ int perm32(int rho) { const int n = rho >> 4, i = rho & 15; return 8 * (i >> 2) + 4 * n + (i & 3); }

struct Unit { int pm, pn; };
struct StaticOrder {
    int nM, nN, nwg, G, c;
    __device__ void init(int M_, int N_, int G_, int c_) { nM = M_ / BM; nN = N_ / BM; nwg = nM * nN; G = G_; c = c_; }
    __device__ bool next(int i, Unit& u) const {
        const long L = (long)i * G + c; if (L >= nwg) return false;
        int wgid = (int)L; { const int q = nwg / NXCD, r = nwg % NXCD, xcd = wgid % NXCD, off = wgid / NXCD; wgid = (xcd < r ? xcd * (q + 1) : r * (q + 1) + (xcd - r) * q) + off; }
        const int nig = WGM * nN, gid = wgid / nig, fm = gid * WGM, gsz = (nM - fm) < WGM ? (nM - fm) : WGM;
        u.pm = fm + ((wgid % nig) % gsz); u.pn = (wgid % nig) / gsz; return true;
    }
};

struct ASrcLinear {
    const char* A; int K;
    __device__ __forceinline__ unsigned voff(int R, int C) const { return (unsigned)(R * K + C) * 2u; }
    __device__ __forceinline__ size_t hstep() const { return (size_t)HALF * K * 2; }
    __device__ __forceinline__ const char* tile(const Unit& u, int t) const { return A + (size_t)u.pm * 2 * hstep() + (size_t)t * (BK * 2); }
};
struct ASrcChunk {
    const char* U; long xoff;
    __device__ __forceinline__ unsigned voff(int R, int C) const { return (unsigned)(R * 256 + C) * 2u; }
    __device__ __forceinline__ size_t hstep() const { return (size_t)HALF * 512; }
    __device__ __forceinline__ const char* tile(const Unit& u, int t) const { return U + (long)(t >> 2) * xoff + (size_t)u.pn * (1024 * 512) + (size_t)u.pm * 2 * hstep() + (size_t)(t & 3) * (BK * 2); }
};
struct Gemm { const bf16_t* Bt; int M, N, K; };

__device__ __forceinline__ unsigned cvt_pk_bf16(float lo, float hi) { unsigned r; asm volatile("v_cvt_pk_bf16_f32 %0, %1, %2" : "=v"(r) : "v"(lo), "v"(hi)); return r; }
__device__ __forceinline__ float shx(float v, int lane, int mask) { return __builtin_bit_cast(float, __builtin_amdgcn_ds_bpermute((lane ^ mask) << 2, __builtin_bit_cast(int, v))); }
#define PG8_XBAR() do { asm volatile("s_waitcnt lgkmcnt(0)" ::: "memory"); __builtin_amdgcn_s_barrier(); asm volatile("" ::: "memory"); } while (0)

constexpr int RSTD_OFF = STAGE_BYTES + 8192 + 1024;
__device__ __forceinline__ void rstd_panel_to_lds(PG8_LAS unsigned char* lds, const float* ssq, int pm, int tid) {
    const int row = tid >> 1, hf = tid & 1, lane = tid & 63;
    const f32x4* p = (const f32x4*)(ssq + (size_t)(pm * BM + row) * 32 + hf * 16);
    const f32x4 a = p[0], b = p[1], c = p[2], d = p[3];
    float s = (((a.x + a.y) + (a.z + a.w)) + ((b.x + b.y) + (b.z + b.w))) + (((c.x + c.y) + (c.z + c.w)) + ((d.x + d.y) + (d.z + d.w)));
    s += shx(s, lane, 1);
    if (hf == 0) ((PG8_LAS float*)(lds + RSTD_OFF))[row] = rsqrtf(s * (1.0f / 1024.f) + 1e-6f);
}
__device__ __forceinline__ void rstd_from_lds(PG8_LAS unsigned char* lds, int wr, int fr, float (&rs)[2][4]) {
#pragma unroll
    for (int ai = 0; ai < 2; ++ai)
#pragma unroll
        for (int m = 0; m < 4; ++m) rs[ai][m] = ((const PG8_LAS float*)(lds + RSTD_OFF))[ai * HALF + wr * 64 + m * 16 + fr];
}
typedef f32x4 AccT[2][2][4][2];

__device__ __forceinline__ f32x4 bf_lo4(unsigned a, unsigned b) { return (f32x4){__uint_as_float(a << 16), __uint_as_float(a & 0xffff0000u), __uint_as_float(b << 16), __uint_as_float(b & 0xffff0000u)}; }
struct EpiRes {
    static constexpr bool PERM = true, AFTER_DRAIN = false, BMAP = false;
    bf16_t* hb; float* ssq; float* fout;
    __device__ __forceinline__ void prologue(const Unit&, PG8_LAS unsigned char*, int) const {}
    __device__ __forceinline__ void operator()(AccT& acc, const Unit& u, int wr, int wc, int fr, int fq, PG8_LAS unsigned char*) const {
        const int col0 = u.pn * BM + wc * 32 + 8 * fq, lane = fr + 16 * fq;
#pragma unroll
        for (int ai = 0; ai < 2; ++ai) {
            u32x4 bs[4][2];
#pragma unroll
            for (int m = 0; m < 4; ++m) { const size_t off = (size_t)(u.pm * BM + ai * HALF + wr * 64 + m * 16 + fr) * 1024 + col0;
                bs[m][0] = *(const u32x4*)(hb + off); bs[m][1] = *(const u32x4*)(hb + off + HALF); }
#pragma unroll
            for (int m = 0; m < 4; ++m) { const int row = u.pm * BM + ai * HALF + wr * 64 + m * 16 + fr; const size_t off = (size_t)row * 1024 + col0;
#pragma unroll
                for (int bj = 0; bj < 2; ++bj) { const u32x4 bb = bs[m][bj];
                    const f32x4 v0 = acc[ai][bj][m][0] + bf_lo4(bb.x, bb.y), v1 = acc[ai][bj][m][1] + bf_lo4(bb.z, bb.w);
                    u32x4 w; w.x = cvt_pk_bf16(v0.x, v0.y); w.y = cvt_pk_bf16(v0.z, v0.w); w.z = cvt_pk_bf16(v1.x, v1.y); w.w = cvt_pk_bf16(v1.z, v1.w);
                    *(u32x4*)(hb + off + bj * HALF) = w;
                    if (fout) { *(f32x4*)(fout + off + bj * HALF) = v0; *(f32x4*)(fout + off + bj * HALF + 4) = v1; }
                    float ss = ((v0.x * v0.x + v0.y * v0.y) + (v0.z * v0.z + v0.w * v0.w)) + ((v1.x * v1.x + v1.y * v1.y) + (v1.z * v1.z + v1.w * v1.w));
                    ss += shx(ss, lane, 16); ss += shx(ss, lane, 32);
                    if (fq == 0) ssq[(size_t)row * 32 + u.pn * 8 + bj * 4 + wc] = ss; } }
            asm volatile("" ::: "memory"); }
    }
};
struct EpiGlu {
    static constexpr bool PERM = true, AFTER_DRAIN = false, BMAP = false;
    bf16_t* hb; float* ssq;
    __device__ __forceinline__ void prologue(const Unit&, PG8_LAS unsigned char*, int) const {}
    __device__ __forceinline__ void operator()(AccT& acc, const Unit& u, int wr, int wc, int fr, int fq, PG8_LAS unsigned char*) const {
        const int col0 = u.pn * HALF + wc * 32 + 8 * fq, lane = fr + 16 * fq;
        u32x4 bs[2][4];
#pragma unroll
        for (int ai = 0; ai < 2; ++ai)
#pragma unroll
            for (int m = 0; m < 4; ++m) bs[ai][m] = *(const u32x4*)(hb + (size_t)(u.pm * BM + ai * HALF + wr * 64 + m * 16 + fr) * 1024 + col0);
#pragma unroll
        for (int ai = 0; ai < 2; ++ai)
#pragma unroll
            for (int m = 0; m < 4; ++m) { const int row = u.pm * BM + ai * HALF + wr * 64 + m * 16 + fr; const size_t off = (size_t)row * 1024 + col0;
                const u32x4 bb = bs[ai][m];
                f32x4 v0 = bf_lo4(bb.x, bb.y), v1 = bf_lo4(bb.z, bb.w);
                const f32x4 a0 = acc[ai][0][m][0], a1 = acc[ai][0][m][1], g0 = acc[ai][1][m][0], g1 = acc[ai][1][m][1];
#pragma unroll
                for (int j = 0; j < 4; ++j) { v0[j] += a0[j] * __builtin_amdgcn_rcpf(1.f + __builtin_amdgcn_exp2f(-1.4426950408889634f * g0[j]));
                                              v1[j] += a1[j] * __builtin_amdgcn_rcpf(1.f + __builtin_amdgcn_exp2f(-1.4426950408889634f * g1[j])); }
                u32x4 w; w.x = cvt_pk_bf16(v0.x, v0.y); w.y = cvt_pk_bf16(v0.z, v0.w); w.z = cvt_pk_bf16(v1.x, v1.y); w.w = cvt_pk_bf16(v1.z, v1.w);
                *(u32x4*)(hb + off) = w;
                float ss = ((v0.x * v0.x + v0.y * v0.y) + (v0.z * v0.z + v0.w * v0.w)) + ((v1.x * v1.x + v1.y * v1.y) + (v1.z * v1.z + v1.w * v1.w));
                ss += shx(ss, lane, 16); ss += shx(ss, lane, 32);
                if (fq == 0) ssq[(size_t)row * 32 + u.pn * 4 + wc] = ss; }
    }
};
struct EpiMlp1 {
    static constexpr bool PERM = true, AFTER_DRAIN = false, BMAP = true;
    const float* ssq; bf16_t* out;
    __device__ __forceinline__ void prologue(const Unit& u, PG8_LAS unsigned char* lds, int tid) const { rstd_panel_to_lds(lds, ssq, u.pm, tid); }
    __device__ __forceinline__ void operator()(AccT& acc, const Unit& u, int wr, int wc, int fr, int fq, PG8_LAS unsigned char* lds) const {
        const int rowbase = u.pm * BM + wr * 64 + fr, col0 = u.pn * BM + wc * 64 + 8 * fq;
        float rs[2][4]; rstd_from_lds(lds, wr, fr, rs);
#pragma unroll
        for (int ai = 0; ai < 2; ++ai)
#pragma unroll
            for (int m = 0; m < 4; ++m) { bf16_t* rowp = out + (size_t)(rowbase + ai * HALF + m * 16) * 4096 + col0; const float r = rs[ai][m];
#pragma unroll
                for (int bj = 0; bj < 2; ++bj) { f32x4 v0 = acc[ai][bj][m][0] * r, v1 = acc[ai][bj][m][1] * r;
#pragma unroll
                    for (int j = 0; j < 4; ++j) { v0[j] = fmaxf(v0[j], 0.f); v0[j] *= v0[j]; v1[j] = fmaxf(v1[j], 0.f); v1[j] *= v1[j]; }
                    u32x4 w; w.x = cvt_pk_bf16(v0[0], v0[1]); w.y = cvt_pk_bf16(v0[2], v0[3]); w.z = cvt_pk_bf16(v1[0], v1[1]); w.w = cvt_pk_bf16(v1[2], v1[3]);
                    *(u32x4*)(rowp + bj * 32) = w; } }
    }
};
template <int NSEG> struct EpiHeadNorm {
    static constexpr bool PERM = true, AFTER_DRAIN = false, BMAP = false;
    const float* ssq;
    const float* rowscale;
    const float* gain0; const float* gain1;
    bf16_t* out; int ldc; int mode; float sc0; int pad;
    __device__ __forceinline__ void prologue(const Unit& u, PG8_LAS unsigned char* lds, int tid) const { if (ssq) rstd_panel_to_lds(lds, ssq, u.pm, tid); }
    __device__ __forceinline__ void operator()(AccT& acc, const Unit& u, int wr, int wc, int fr, int fq, PG8_LAS unsigned char* lds) const {
        const int rowbase = u.pm * BM + wr * 64 + fr, col0 = u.pn * BM + wc * 32 + 8 * fq;
        bool normed; const float* g; float psc = 1.f;
        if (mode == 0) { normed = true; g = gain0; psc = sc0; }
        else if (mode == 1) { normed = (u.pn & 7) < 4; g = gain0 + 256 * (u.pn >> 3); }
        else { const int which = u.pn >> 2; normed = which < 2; g = which == 0 ? gain0 : gain1; psc = which == 0 ? sc0 : 1.f; }
        float rs[2][4];
        if (ssq) rstd_from_lds(lds, wr, fr, rs);
        else {
#pragma unroll
            for (int ai = 0; ai < 2; ++ai)
#pragma unroll
                for (int m = 0; m < 4; ++m) rs[ai][m] = rowscale[rowbase + ai * HALF + m * 16];
        }
#pragma unroll
        for (int ai = 0; ai < 2; ++ai)
#pragma unroll
            for (int m = 0; m < 4; ++m)
#pragma unroll
                for (int bj = 0; bj < 2; ++bj)
#pragma unroll
                    for (int n = 0; n < 2; ++n) acc[ai][bj][m][n] = acc[ai][bj][m][n] * rs[ai][m];
        float rn[2][4][2];
        if (normed) {
            PG8_LAS float* P = (PG8_LAS float*)(lds + XCH_OFF);
#pragma unroll
            for (int ai = 0; ai < 2; ++ai)
#pragma unroll
                for (int m = 0; m < 4; ++m) { float s[2];
#pragma unroll
                    for (int bj = 0; bj < 2; ++bj) { const f32x4 a = acc[ai][bj][m][0], b = acc[ai][bj][m][1];
                        s[bj] = ((a.x * a.x + a.y * a.y) + (a.z * a.z + a.w * a.w)) + ((b.x * b.x + b.y * b.y) + (b.z * b.z + b.w * b.w)); }
                    if (NSEG == 1) { s[0] += s[1]; s[1] = 0.f; }
#pragma unroll
                    for (int sg = 0; sg < NSEG; ++sg) { float t = s[sg]; t += shx(t, fr + 16 * fq, 16); t += shx(t, fr + 16 * fq, 32);
                        if (fq == 0) P[((ai * HALF + wr * 64 + m * 16 + fr) * 2 + sg) * 4 + wc] = t; } }
            PG8_XBAR();
#pragma unroll
            for (int ai = 0; ai < 2; ++ai)
#pragma unroll
                for (int m = 0; m < 4; ++m)
#pragma unroll
                    for (int sg = 0; sg < NSEG; ++sg) { const f32x4 t = *(const PG8_LAS f32x4*)(P + ((ai * HALF + wr * 64 + m * 16 + fr) * 2 + sg) * 4);
                        rn[ai][m][sg] = rsqrtf(((t.x + t.y) + (t.z + t.w)) * (NSEG == 1 ? 1.0f / 256.f : 1.0f / 128.f) + 1e-6f) * psc; }
        }
        f32x4 gv[2][2];
#pragma unroll
        for (int bj = 0; bj < 2; ++bj)
#pragma unroll
            for (int n = 0; n < 2; ++n) gv[bj][n] = normed ? *(const f32x4*)(g + (NSEG == 1 ? bj * HALF : 0) + wc * 32 + 8 * fq + 4 * n) : (f32x4){1.f, 1.f, 1.f, 1.f};
#pragma unroll
        for (int ai = 0; ai < 2; ++ai)
#pragma unroll
            for (int m = 0; m < 4; ++m) { bf16_t* rowp = out + (size_t)(rowbase + ai * HALF + m * 16) * ldc + col0;
#pragma unroll
                for (int bj = 0; bj < 2; ++bj) { const float r = normed ? rn[ai][m][NSEG == 1 ? 0 : bj] : 1.f;
                    const f32x4 v0 = acc[ai][bj][m][0] * gv[bj][0] * r, v1 = acc[ai][bj][m][1] * gv[bj][1] * r;
                    u32x4 w; w.x = cvt_pk_bf16(v0[0], v0[1]); w.y = cvt_pk_bf16(v0[2], v0[3]); w.z = cvt_pk_bf16(v1[0], v1[1]); w.w = cvt_pk_bf16(v1[2], v1[3]);
                    *(u32x4*)(rowp + bj * HALF) = w; } }
    }
};
struct EpiS5State {
    static constexpr bool PERM = true, AFTER_DRAIN = false, BMAP = false;
    bf16_t* F;
    __device__ __forceinline__ void prologue(const Unit&, PG8_LAS unsigned char*, int) const {}
    __device__ __forceinline__ void operator()(AccT& acc, const Unit& u, int wr, int wc, int fr, int fq, PG8_LAS unsigned char*) const {
        const int col0 = wc * 32 + 8 * fq;
#pragma unroll
        for (int ai = 0; ai < 2; ++ai)
#pragma unroll
            for (int m = 0; m < 4; ++m) { bf16_t* rowp = F + ((size_t)u.pn * 1024 + u.pm * BM + ai * HALF + wr * 64 + m * 16 + fr) * 256 + col0;
#pragma unroll
                for (int bj = 0; bj < 2; ++bj) { const f32x4 v0 = acc[ai][bj][m][0], v1 = acc[ai][bj][m][1];
                    u32x4 w; w.x = cvt_pk_bf16(v0[0], v0[1]); w.y = cvt_pk_bf16(v0[2], v0[3]); w.z = cvt_pk_bf16(v1[0], v1[1]); w.w = cvt_pk_bf16(v1[2], v1[3]);
                    *(u32x4*)(rowp + bj * HALF) = w; } }
    }
};
__device__ __forceinline__ float gelu_tanh_fast(float x) {
    const float z2 = 2.302208198f * (x + 0.044715f * x * x * x);
    const float e = __builtin_amdgcn_exp2f(z2);
    return x - x * __builtin_amdgcn_rcpf(1.f + e);
}
struct EpiS5Out {
    static constexpr bool PERM = true, AFTER_DRAIN = false, BMAP = false;
    bf16_t* G;
    __device__ __forceinline__ void prologue(const Unit&, PG8_LAS unsigned char*, int) const {}
    __device__ __forceinline__ void operator()(AccT& acc, const Unit& u, int wr, int wc, int fr, int fq, PG8_LAS unsigned char*) const {
#pragma unroll
        for (int ai = 0; ai < 2; ++ai)
#pragma unroll
            for (int m = 0; m < 4; ++m) { const int crow = u.pm * BM + ai * HALF + wr * 64 + m * 16 + fr;
#pragma unroll
                for (int bj = 0; bj < 2; ++bj) { const int c = bj * HALF + wc * 32 + 8 * fq, s = c >> 4, ch0 = c & 15;
                    f32x4 v0 = acc[ai][bj][m][0], v1 = acc[ai][bj][m][1];
#pragma unroll
                    for (int j = 0; j < 4; ++j) { v0[j] = gelu_tanh_fast(v0[j]); v1[j] = gelu_tanh_fast(v1[j]); }
                    u32x4 w; w.x = cvt_pk_bf16(v0[0], v0[1]); w.y = cvt_pk_bf16(v0[2], v0[3]); w.z = cvt_pk_bf16(v1[0], v1[1]); w.w = cvt_pk_bf16(v1[2], v1[3]);
                    *(u32x4*)(G + ((size_t)crow * 16 + s) * 1024 + u.pn * 16 + ch0) = w; } }
    }
};

template <class Epi, class ASrc>
__device__ __forceinline__ void gemm_phase(PG8_LAS unsigned char* lds, const Gemm g, const ASrc AS, const StaticOrder& S, const Epi& E, const int tid  ) {
    const int wid = __builtin_amdgcn_readfirstlane(tid >> 6), lane = tid & 63, wr = wid >> 2, wc = wid & 3, fr = lane & 15, fq = lane >> 4;
    const int K = g.K, nt = K / BK;
    unsigned voffA[2], voffB[2], voffB1[2];
#pragma unroll
    for (int i = 0; i < 2; ++i) { int R, C; stage_rc(tid * 16 + i * 8192, R, C); const int Rb = Epi::PERM ? ((R & ~31) + perm32(R & 31)) : R;
        voffA[i] = AS.voff(R, C);
        if (Epi::BMAP) { const int Rc = 64 * (R >> 5) + perm32(R & 31); voffB[i] = (unsigned)(Rc * K + C) * 2u; voffB1[i] = (unsigned)((Rc + 32) * K + C) * 2u; }
        else { voffB[i] = (unsigned)(Rb * K + C) * 2u; voffB1[i] = voffB[i] + (unsigned)(HALF * K * 2); } }
    const size_t kstep = (size_t)(BK * 2);
    const size_t hstepB = (size_t)HALF * K * 2, hstepA = AS.hstep();
    const unsigned ldsw = (unsigned)wid * 1024u;
    const int aoff = lds_byte(wr * 64 + fr, fq * 8), boff = lds_byte(wc * 32 + fr, fq * 8);
#define PG8_SA(b, h) (((b) * 2 + (h)) * HTB)
#define PG8_SB(b, h) ((4 + (b) * 2 + (h)) * HTB)
#define PG8_STAGE(bufoff, gbase, voff) do { _Pragma("unroll") for (int _i = 0; _i < 2; ++_i) \
        __builtin_amdgcn_global_load_lds((const unsigned*)((const char*)(gbase) + (voff)[_i]), (PG8_LAS unsigned*)(lds + (bufoff) + ldsw + _i * 8192), 16, 0, 0); } while (0)
#define PG8_LDA(dst, b, h) do { _Pragma("unroll") for (int m = 0; m < 4; ++m) _Pragma("unroll") for (int k = 0; k < 2; ++k) dst[m][k] = *(const PG8_LAS bf16x8*)(lds + PG8_SA(b, h) + aoff + m * 2048 + k * 1024); } while (0)
#define PG8_LDB(dst, b, h) do { _Pragma("unroll") for (int n = 0; n < 2; ++n) _Pragma("unroll") for (int k = 0; k < 2; ++k) dst[n][k] = *(const PG8_LAS bf16x8*)(lds + PG8_SB(b, h) + boff + n * 2048 + k * 1024); } while (0)
#define PG8_MMA(ai, bj, At, Bt) do { __builtin_amdgcn_s_setprio(1); _Pragma("unroll") for (int m = 0; m < 4; ++m) _Pragma("unroll") for (int n = 0; n < 2; ++n) _Pragma("unroll") for (int k = 0; k < 2; ++k) \
        acc[ai][bj][m][n] = __builtin_amdgcn_mfma_f32_16x16x32_bf16(Bt[n][k], At[m][k], acc[ai][bj][m][n], 0, 0, 0); __builtin_amdgcn_s_setprio(0); } while (0)
#define PG8_WAIT_V(n) asm volatile("s_waitcnt vmcnt(" #n ")" ::: "memory")
#define PG8_WAIT_L(n) asm volatile("s_waitcnt lgkmcnt(" #n ")" ::: "memory")
#define PG8_BAR __builtin_amdgcn_s_barrier()
#define PG8_SCHED __builtin_amdgcn_sched_barrier(0)
    Unit cur, nxt; int ui = 0;
    if (!S.next(0, cur)) return;
    AccT acc;
#pragma unroll
    for (int a = 0; a < 2; ++a)
#pragma unroll
        for (int b = 0; b < 2; ++b)
#pragma unroll
            for (int m = 0; m < 4; ++m)
#pragma unroll
                for (int n = 0; n < 2; ++n) acc[a][b][m][n] = (f32x4){0.f, 0.f, 0.f, 0.f};
    bf16x8 At[4][2], B0[2][2], B1[2][2];
    const char* cB = (const char*)g.Bt + (size_t)cur.pn * 2 * hstepB;
    { const char* cA0 = AS.tile(cur, 0); const char* cA1 = AS.tile(cur, 1);
      PG8_STAGE(PG8_SB(0, 0), cB, voffB); PG8_STAGE(PG8_SB(0, 1), cB, voffB1); PG8_STAGE(PG8_SA(0, 0), cA0, voffA); PG8_STAGE(PG8_SA(0, 1), cA0 + hstepA, voffA);
      E.prologue(cur, lds, tid);
      if (wr == 1) PG8_BAR;
      PG8_WAIT_V(2); PG8_BAR;
      PG8_STAGE(PG8_SB(1, 0), cB + kstep, voffB); PG8_STAGE(PG8_SA(1, 0), cA1, voffA); PG8_STAGE(PG8_SB(1, 1), cB + kstep, voffB1);
      PG8_WAIT_V(6); PG8_BAR; }
    for (;;) {
        const bool has_next = S.next(ui + 1, nxt);
        const Unit nu = has_next ? nxt : cur;
        const char* nB = (const char*)g.Bt + (size_t)nu.pn * 2 * hstepB;
#pragma unroll 1
        for (int t = 0; t < nt; t += 2) {
            const bool last = (t == nt - 2);
            const char* a1 = AS.tile(cur, t + 1);
            const char* a2 = last ? AS.tile(nu, 0) : AS.tile(cur, t + 2); const char* b2 = last ? nB : cB + (size_t)(t + 2) * kstep;
            const char* a3 = last ? AS.tile(nu, 1) : AS.tile(cur, t + 3); const char* b3 = b2 + kstep;
            PG8_LDB(B0, 0, 0); PG8_LDB(B1, 0, 1); PG8_SCHED; PG8_LDA(At, 0, 0); PG8_STAGE(PG8_SA(1, 1), a1 + hstepA, voffA);
            PG8_WAIT_V(8); PG8_WAIT_L(0); PG8_BAR; PG8_MMA(0, 0, At, B0); PG8_MMA(0, 1, At, B1); PG8_BAR; PG8_SCHED;
            PG8_LDA(At, 0, 1); PG8_STAGE(PG8_SB(0, 0), b2, voffB); PG8_STAGE(PG8_SB(0, 1), b2, voffB1); PG8_STAGE(PG8_SA(0, 0), a2, voffA);
            PG8_WAIT_V(8); PG8_WAIT_L(0); PG8_BAR; PG8_MMA(1, 0, At, B0); PG8_MMA(1, 1, At, B1); PG8_BAR; PG8_SCHED;
            PG8_LDB(B0, 1, 0); PG8_LDB(B1, 1, 1); PG8_SCHED; PG8_LDA(At, 1, 0); PG8_STAGE(PG8_SA(0, 1), a2 + hstepA, voffA);
            PG8_WAIT_V(8); PG8_WAIT_L(0); PG8_BAR; PG8_MMA(0, 0, At, B0); PG8_MMA(0, 1, At, B1); PG8_BAR; PG8_SCHED;
            PG8_LDA(At, 1, 1); PG8_STAGE(PG8_SB(1, 0), b3, voffB); PG8_STAGE(PG8_SB(1, 1), b3, voffB1); PG8_STAGE(PG8_SA(1, 0), a3, voffA);
            PG8_WAIT_V(8); PG8_WAIT_L(0); PG8_BAR; PG8_MMA(1, 0, At, B0); PG8_MMA(1, 1, At, B1); PG8_BAR; PG8_SCHED;
        }
        if (wr == 0) PG8_BAR;
        E(acc, cur, wr, wc, fr, fq, lds);
        if (!has_next) break;
#pragma unroll
        for (int a = 0; a < 2; ++a)
#pragma unroll
            for (int b = 0; b < 2; ++b)
#pragma unroll
                for (int m = 0; m < 4; ++m)
#pragma unroll
                    for (int n = 0; n < 2; ++n) acc[a][b][m][n] = (f32x4){0.f, 0.f, 0.f, 0.f};
        cur = nxt; cB = nB; ++ui;
        if (wr == 1) PG8_BAR;
    }
    PG8_WAIT_V(0);
    PG8_BAR;
#undef PG8_SA
#undef PG8_SB
#undef PG8_STAGE
#undef PG8_LDA
#undef PG8_LDB
#undef PG8_MMA
#undef PG8_WAIT_V
#undef PG8_WAIT_L
#undef PG8_BAR
#undef PG8_SCHED
}
}
constexpr int NWAVES = 8;
constexpr int RING_BYTES = 131072;
constexpr int XCH_BYTES = 8192;
constexpr int MISC_OFF = RING_BYTES + XCH_BYTES;
constexpr int LDS_BYTES = 147456;

constexpr size_t W_XQ = 0, W_XO = 2 * MiB, W_1 = 4 * MiB, W_2 = 12 * MiB, W_MIX = 20 * MiB;
constexpr size_t W_GLU = W_MIX, W_BST = W_MIX + 4 * MiB, W_BOUT = W_MIX + 12 * MiB;
constexpr size_t W_QKV = W_MIX, W_AO = W_MIX + 18 * MiB;
constexpr size_t BIG_F = 0, BIG_XB = 64 * MiB, BIG_WKV = 96 * MiB;
constexpr int CW_BAR = 4096;

#define GAS __attribute__((address_space(1)))
#define LAS __attribute__((address_space(3)))
typedef GAS unsigned gu32;
#define RLX_AGENT __ATOMIC_RELAXED, __HIP_MEMORY_SCOPE_AGENT
#define LDS_WAIT() asm volatile("s_waitcnt lgkmcnt(0)" ::: "memory")

#define XB_TMO      128
#define XB_XCNT(j)  (256  + 64 * (j))
#define XB_XSUB(j)  (1280 + 64 * (j))
#define XB_XGEN(j)  (2304 + 64 * (j))
#define XB_TOP      3328
#define XB_TOPGEN   3392
#define XCD_BAR_WORDS 3456
#define XB_SPIN_CAP (1u << 22)
__device__ __forceinline__ unsigned xb_ld(unsigned* p)              { return __hip_atomic_load(p, __ATOMIC_RELAXED, __HIP_MEMORY_SCOPE_AGENT); }
__device__ __forceinline__ unsigned xb_add(unsigned* p, unsigned v) { return __hip_atomic_fetch_add(p, v, __ATOMIC_RELAXED, __HIP_MEMORY_SCOPE_AGENT); }
__device__ __forceinline__ unsigned xb_xcc_id() { return (unsigned)__builtin_amdgcn_s_getreg((3 << 11) | 20) & 0xFu; }
#define XB_SPIN(cond, bar) do { unsigned _sp = 0; while (cond) { __builtin_amdgcn_s_sleep(1); \
    if ((++_sp & 255u) == 0u) { if (xb_ld(&(bar)[XB_TMO])) break; if (_sp > XB_SPIN_CAP) { atomicAdd(&(bar)[XB_TMO], 1u); break; } } } } while (0)
struct XcdBarrier { unsigned* bar; unsigned x; volatile LAS unsigned* st; };
__device__ __forceinline__ XcdBarrier xcd_barrier_post(unsigned* bar, volatile LAS unsigned* st) {
    XcdBarrier b; b.bar = bar; b.x = xb_xcc_id(); b.st = st;
    if (threadIdx.x == 0) (void)xb_add(&bar[XB_XCNT(b.x)], 1u);
    return b;
}
__device__ __forceinline__ void xcd_barrier_complete(unsigned* bar, unsigned x, unsigned& nloc, unsigned& nx) {
    const unsigned G = gridDim.x * gridDim.y * gridDim.z;
    unsigned sum, cnt, mine, sp = 0u;
    for (;;) {
        sum = 0u; cnt = 0u; mine = 0u;
#pragma unroll
        for (unsigned j = 0; j < 16; ++j) { const unsigned c = xb_ld(&bar[XB_XCNT(j)]); sum += c; cnt += (c > 0u) ? 1u : 0u; mine = (j == x) ? c : mine; }
        if (sum == G) break;
        __builtin_amdgcn_s_sleep(1);
        if ((++sp & 255u) == 0u) { if (xb_ld(&bar[XB_TMO])) break; if (sp > XB_SPIN_CAP) { atomicAdd(&bar[XB_TMO], 1u); break; } }
    }
    nloc = mine > 0u ? mine : 1u; nx = cnt > 0u ? cnt : 1u;
}
__device__ __forceinline__ void xcd_barrier(const XcdBarrier& b) {
    asm volatile("s_waitcnt vmcnt(0)" ::: "memory");
    __syncthreads();
    if (threadIdx.x == 0) {
        unsigned* bar = b.bar;
        __builtin_amdgcn_s_waitcnt(0);
        unsigned nloc = b.st[0], nx = b.st[1];
        if (nloc == 0u) { xcd_barrier_complete(bar, b.x, nloc, nx); b.st[0] = nloc; b.st[1] = nx; }
        const unsigned old = xb_add(&bar[XB_XSUB(b.x)], 1u);
        const unsigned gen = old / nloc;
        if (old + 1u == (gen + 1u) * nloc) {
            __builtin_amdgcn_fence(__ATOMIC_RELEASE, "agent");
            asm volatile("s_waitcnt vmcnt(0)" ::: "memory");
            const unsigned og = xb_add(&bar[XB_TOP], 1u);
            const unsigned tg = og / nx;
            if (og + 1u == (tg + 1u) * nx) xb_add(&bar[XB_TOPGEN], 1u);
            else XB_SPIN(xb_ld(&bar[XB_TOPGEN]) == tg, bar);
            __builtin_amdgcn_fence(__ATOMIC_ACQUIRE, "agent");
            xb_add(&bar[XB_XGEN(b.x)], 1u);
            asm volatile("s_waitcnt vmcnt(0)" ::: "memory");
        } else {
            XB_SPIN(xb_ld(&bar[XB_XGEN(b.x)]) == gen, bar);
            __builtin_amdgcn_fence(__ATOMIC_ACQUIRE, "agent");
            asm volatile("s_waitcnt vmcnt(0)" ::: "memory");
        }
    }
    __syncthreads();
}

__device__ __forceinline__ void conv_item(const float* W, int ldw, int K, int c0, int k0, const float* gain, bf16_t* Wt, int n0, LAS float* scr, int lane) {
    f32x4 v[16];
    const int kr = lane >> 4, n4 = (lane & 15) * 4;
    const float* src = W + (size_t)(k0 + kr) * ldw + c0 + n4;
#pragma unroll
    for (int i = 0; i < 16; ++i) v[i] = *(const f32x4*)(src + (size_t)(4 * i) * ldw);
    if (gain) {
#pragma unroll
        for (int i = 0; i < 16; ++i) v[i] = v[i] * gain[k0 + 4 * i + kr];
    }
#pragma unroll
    for (int i = 0; i < 16; ++i) { const int k = 4 * i + kr; *(LAS f32x4*)(scr + k * 64 + (n4 ^ (((k >> 3) & 7) << 2))) = v[i]; }
    LDS_WAIT(); asm volatile("" ::: "memory");
    const int c = lane & 7;
#pragma unroll
    for (int j = 0; j < 8; ++j) { const int n = (lane >> 3) + 8 * j; const LAS float* s = scr + (8 * c) * 64 + (n ^ (c << 2));
        u32x4 o; o.x = pg8::cvt_pk_bf16(s[0 * 64], s[1 * 64]); o.y = pg8::cvt_pk_bf16(s[2 * 64], s[3 * 64]); o.z = pg8::cvt_pk_bf16(s[4 * 64], s[5 * 64]); o.w = pg8::cvt_pk_bf16(s[6 * 64], s[7 * 64]);
        *(u32x4*)(Wt + (size_t)(n0 + n) * K + k0 + 8 * c) = o; }
    LDS_WAIT(); asm volatile("" ::: "memory");
}
enum { MAP_ID = 0, MAP_GLU = 1, MAP_QKV = 2 };
__device__ __forceinline__ int map_col(int kind, int arg, int n0) {
    if (kind == MAP_GLU) { const int pn = n0 >> 8, w = n0 & 255; return (w >> 7) * 1024 + pn * 128 + (w & 127); }
    if (kind == MAP_QKV) { return ((n0 >> 10) * 3 + arg) * 1024 + (n0 & 1023); }
    return n0;
}
__device__ __forceinline__ void conv_matrix(const float* W, int ldw, int K, int N, int kind, int arg, const float* gain, bf16_t* Wt, LAS float* scr, int lane, int gw, int NGW, int& rot) {
    const int nblk = N / 64, nitems = (K / 64) * nblk;
    for (int it = (gw + NGW - rot) % NGW; it < nitems; it += NGW) { const int kb = it / nblk, nb = it % nblk; conv_item(W, ldw, K, map_col(kind, arg, nb * 64), kb * 64, gain, Wt, nb * 64, scr, lane); }
    rot = (rot + nitems) % NGW;
}
__device__ __forceinline__ float wsum_l(float v, int lane) {
#pragma unroll
    for (int o = 1; o < 64; o <<= 1) v += pg8::shx(v, lane, o);
    return v;
}
__device__ __forceinline__ float row_f32_to_bf16(const float* xrow, bf16_t* oraw, bf16_t* onorm, int lane) {
    const f32x4* xr = (const f32x4*)xrow + lane;
    f32x4 v[4]; float s = 0.f;
#pragma unroll
    for (int j = 0; j < 4; ++j) { v[j] = xr[64 * j]; s += (v[j].x * v[j].x + v[j].y * v[j].y) + (v[j].z * v[j].z + v[j].w * v[j].w); }
    const float rstd = rsqrtf(wsum_l(s, lane) * (1.0f / DM) + EPS);
    if (oraw) { u32x2* o = (u32x2*)oraw + lane;
#pragma unroll
        for (int j = 0; j < 4; ++j) { u32x2 w; w.x = pk2(v[j].x, v[j].y); w.y = pk2(v[j].z, v[j].w); o[64 * j] = w; } }
    if (onorm) { u32x2* o = (u32x2*)onorm + lane;
#pragma unroll
        for (int j = 0; j < 4; ++j) { u32x2 w; w.x = pk2(v[j].x * rstd, v[j].y * rstd); w.y = pk2(v[j].z * rstd, v[j].w * rstd); o[64 * j] = w; } }
    return rstd;
}
template <bool F32SRC> __device__ __forceinline__ void unorm_chunk(LAS unsigned char* lds, const float* xsrc, bf16_t* hbio, bf16_t* Ug, int chunk, const int tid) {
    const int lane = tid & 63, wid = __builtin_amdgcn_readfirstlane(tid >> 6);
    LAS unsigned char* T = lds;
#pragma unroll
    for (int rr = 0; rr < 2; ++rr) { const int s = 2 * wid + rr; const size_t row = (size_t)chunk * 16 + s;
        if (F32SRC) { const f32x4* xr = (const f32x4*)(xsrc + row * DM) + lane; f32x4 v[4]; float ss = 0.f;
#pragma unroll
            for (int j = 0; j < 4; ++j) { v[j] = xr[64 * j]; ss += (v[j].x * v[j].x + v[j].y * v[j].y) + (v[j].z * v[j].z + v[j].w * v[j].w); }
            const float rstd = rsqrtf(wsum_l(ss, lane) * (1.0f / DM) + EPS);
            u32x2* o = (u32x2*)(hbio + row * DM) + lane;
#pragma unroll
            for (int j = 0; j < 4; ++j) { u32x2 w; w.x = pg8::cvt_pk_bf16(v[j].x, v[j].y); w.y = pg8::cvt_pk_bf16(v[j].z, v[j].w); o[64 * j] = w;
                u32x2 q; q.x = pg8::cvt_pk_bf16(v[j].x * rstd, v[j].y * rstd); q.y = pg8::cvt_pk_bf16(v[j].z * rstd, v[j].w * rstd); *(LAS u32x2*)(T + s * 2080 + (64 * j + lane) * 8) = q; }
        } else { const u32x4* xr = (const u32x4*)(hbio + row * DM) + lane; u32x4 w[2]; float v[16]; float ss = 0.f;
#pragma unroll
            for (int j = 0; j < 2; ++j) { w[j] = xr[64 * j];
                v[8 * j + 0] = __uint_as_float(w[j].x << 16); v[8 * j + 1] = __uint_as_float(w[j].x & 0xffff0000u); v[8 * j + 2] = __uint_as_float(w[j].y << 16); v[8 * j + 3] = __uint_as_float(w[j].y & 0xffff0000u);
                v[8 * j + 4] = __uint_as_float(w[j].z << 16); v[8 * j + 5] = __uint_as_float(w[j].z & 0xffff0000u); v[8 * j + 6] = __uint_as_float(w[j].w << 16); v[8 * j + 7] = __uint_as_float(w[j].w & 0xffff0000u); }
#pragma unroll
            for (int i = 0; i < 16; ++i) ss += v[i] * v[i];
            const float rstd = rsqrtf(wsum_l(ss, lane) * (1.0f / DM) + EPS);
#pragma unroll
            for (int j = 0; j < 2; ++j) { u32x4 q; q.x = pg8::cvt_pk_bf16(v[8 * j] * rstd, v[8 * j + 1] * rstd); q.y = pg8::cvt_pk_bf16(v[8 * j + 2] * rstd, v[8 * j + 3] * rstd);
                q.z = pg8::cvt_pk_bf16(v[8 * j + 4] * rstd, v[8 * j + 5] * rstd); q.w = pg8::cvt_pk_bf16(v[8 * j + 6] * rstd, v[8 * j + 7] * rstd); *(LAS u32x4*)(T + s * 2080 + (64 * j + lane) * 16) = q; } }
    }
    LDS_WAIT(); __syncthreads();
#pragma unroll
    for (int i = 0; i < 4; ++i) { const int gq = 8 * wid + 2 * i + (lane >> 5), l = lane & 31, s = l >> 1, hf = l & 1;
        const u32x4 q = *(const LAS u32x4*)(T + s * 2080 + gq * 32 + hf * 16);
        *(u32x4*)(Ug + ((size_t)gq * 1024 + chunk) * 256 + l * 8) = q; }
    LDS_WAIT(); __syncthreads();
}

struct S5In { const float *lam_re, *lam_im, *log_dt, *b_re, *b_im, *c_re, *c_im, *dskip, *gain; };
typedef float f32x2v __attribute__((ext_vector_type(2)));
__device__ __forceinline__ void s5_gen(LAS unsigned char* lds, const S5In P, int g, int q, bf16_t* Bst, bf16_t* Bout, const int tid) {
    LAS f32x2v* pw = (LAS f32x2v*)lds;
    LAS f32x2v* bb = (LAS f32x2v*)(lds + 17408);
    LAS f32x2v* cc = (LAS f32x2v*)(lds + 33792);
    LAS float* kt = (LAS float*)(lds + 50176);
    if (tid < 128) {
        const int di = tid >> 6, p = tid & 63, gp = (di * 64 + g) * 64 + p;
        const float dt = expf(P.log_dt[di * 64 + g]);
        const float lr = P.lam_re[gp], li = P.lam_im[gp];
        const float mag = expf(lr * dt), ang = li * dt;
        const float ar = mag * cosf(ang), ai = mag * sinf(ang);
        const float nr = ar - 1.0f, ni = ai, den = lr * lr + li * li;
        const float fr = (nr * lr + ni * li) / den, fi = (ni * lr - nr * li) / den;
        float wr = 1.0f, wi = 0.0f;
        for (int k = 0; k <= 16; ++k) { pw[(di * 64 + p) * 17 + k] = (f32x2v){wr, wi}; const float t = wr * ar - wi * ai; wi = wr * ai + wi * ar; wr = t; }
        for (int c = 0; c < 16; ++c) { const float br = P.b_re[(size_t)gp * 16 + c], bi = P.b_im[(size_t)gp * 16 + c];
            bb[(di * 64 + p) * 16 + c] = (f32x2v){fr * br - fi * bi, fr * bi + fi * br}; }
    }
    for (int e = tid; e < 2048; e += 512) { const int di = e >> 10, c = (e >> 6) & 15, p = e & 63; const size_t o = ((size_t)(di * 64 + g) * 16 + c) * 64 + p; cc[e] = (f32x2v){P.c_re[o], P.c_im[o]}; }
    __syncthreads();
    { const int di = tid >> 8, k = (tid >> 4) & 15, chb = (tid >> 2) & 3, c2b = tid & 3;
      float acc[4][4];
#pragma unroll
      for (int a_ = 0; a_ < 4; ++a_)
#pragma unroll
          for (int b_ = 0; b_ < 4; ++b_) acc[a_][b_] = 0.f;
      for (int p = 0; p < 64; ++p) { const f32x2v w = pw[(di * 64 + p) * 17 + k]; float zr[4], zi[4];
#pragma unroll
          for (int b_ = 0; b_ < 4; ++b_) { const f32x2v b = bb[(di * 64 + p) * 16 + 4 * c2b + b_]; zr[b_] = w.x * b.x - w.y * b.y; zi[b_] = w.x * b.y + w.y * b.x; }
#pragma unroll
          for (int a_ = 0; a_ < 4; ++a_) { const f32x2v C = cc[(di * 16 + 4 * chb + a_) * 64 + p];
#pragma unroll
              for (int b_ = 0; b_ < 4; ++b_) acc[a_][b_] += C.x * zr[b_] - C.y * zi[b_]; } }
#pragma unroll
      for (int a_ = 0; a_ < 4; ++a_)
#pragma unroll
          for (int b_ = 0; b_ < 4; ++b_) kt[((di * 16 + k) * 16 + 4 * chb + a_) * 16 + 4 * c2b + b_] = acc[a_][b_]; }
    __syncthreads();
    { const int di = q >> 1, ri = q & 1;
      for (int cid = tid; cid < 2048; cid += 512) { const int nl = cid >> 5, k0 = (cid & 31) * 8, r = k0 >> 4, ch0 = k0 & 15;
        const f32x2v w = pw[(di * 64 + nl) * 17 + (di == 0 ? 15 - r : r)]; float v[8];
#pragma unroll
        for (int j = 0; j < 8; ++j) { const f32x2v b = bb[(di * 64 + nl) * 16 + ch0 + j]; const float zr = w.x * b.x - w.y * b.y, zi = w.x * b.y + w.y * b.x; v[j] = (ri == 0 ? zr : zi) * P.gain[g * 16 + ch0 + j]; }
        u32x4 o; o.x = pk2(v[0], v[1]); o.y = pk2(v[2], v[3]); o.z = pk2(v[4], v[5]); o.w = pk2(v[6], v[7]);
        *(u32x4*)(Bst + ((size_t)g * 256 + q * 64 + nl) * 256 + k0) = o; } }
    for (int cid = tid; cid < 4096; cid += 512) { const int nl = cid >> 6, k0 = (cid & 63) * 8, n = q * 64 + nl, s = n >> 4, ch = n & 15; float v[8];
        if (k0 < 256) { const int r = k0 >> 4, c0 = k0 & 15;
#pragma unroll
            for (int j = 0; j < 8; ++j) { const int c2 = c0 + j; float t = 0.f;
                if (r <= s) t += kt[((0 * 16 + (s - r)) * 16 + ch) * 16 + c2];
                if (r >= s) t += kt[((1 * 16 + (r - s)) * 16 + ch) * 16 + c2];
                if (r == s && c2 == ch) t += P.dskip[g * 16 + ch];
                v[j] = t * P.gain[g * 16 + c2]; }
        } else { const int kk = k0 - 256, di = kk >> 7, ri = (kk >> 6) & 1, p0 = kk & 63;
#pragma unroll
            for (int j = 0; j < 8; ++j) { const int p = p0 + j; const f32x2v C = cc[(di * 16 + ch) * 64 + p], w = pw[(di * 64 + p) * 17 + (di == 0 ? s + 1 : 16 - s)];
                v[j] = ri == 0 ? (C.x * w.x - C.y * w.y) : -(C.x * w.y + C.y * w.x); } }
        u32x4 o; o.x = pk2(v[0], v[1]); o.y = pk2(v[2], v[3]); o.z = pk2(v[4], v[5]); o.w = pk2(v[6], v[7]);
        *(u32x4*)(Bout + ((size_t)g * 256 + n) * 512 + k0) = o; }
    __syncthreads();
}

__device__ __forceinline__ void s5_scan_bg(LAS unsigned char* lds, const S5In P, const bf16_t* F, bf16_t* XB, int b, int g, const int tid) {
    const int lane = tid & 63, wid = __builtin_amdgcn_readfirstlane(tid >> 6), p = lane;
    LAS f32x2v* E = (LAS f32x2v*)lds;
    LAS f32x2v* XI = (LAS f32x2v*)(lds + 16384);
    float a1r[2], a1i[2], a16r[2], a16i[2];
#pragma unroll
    for (int di = 0; di < 2; ++di) { const int gp = (di * 64 + g) * 64 + p;
        const float dt = expf(P.log_dt[di * 64 + g]); const float lr = P.lam_re[gp], li = P.lam_im[gp];
        const float mag = expf(lr * dt), ang = li * dt; float ar = mag * cosf(ang), ai = mag * sinf(ang);
#pragma unroll
        for (int sq = 0; sq < 4; ++sq) { const float t = ar * ar - ai * ai; ai = 2.f * ar * ai; ar = t; }
        a1r[di] = ar; a1i[di] = ai;
#pragma unroll
        for (int sq = 0; sq < 4; ++sq) { const float t = ar * ar - ai * ai; ai = 2.f * ar * ai; ar = t; }
        a16r[di] = ar; a16i[di] = ai; }
    const bf16_t* Fb = F + ((size_t)g * 1024 + b * 256) * 256;
#pragma unroll 1
    for (int jj = 0; jj < 4; ++jj) { const int job = wid + 8 * jj, di = job >> 4, seg = job & 15; float fr[16], fi[16];
#pragma unroll
        for (int j = 0; j < 16; ++j) { const int c = di == 0 ? seg * 16 + j : 255 - (seg * 16 + j); const bf16_t* fp = Fb + (size_t)c * 256 + di * 128 + p; fr[j] = bf2f(fp[0]); fi[j] = bf2f(fp[64]); }
        const float ar = di ? a1r[1] : a1r[0], ai = di ? a1i[1] : a1i[0]; float xr = 0.f, xi = 0.f;
#pragma unroll
        for (int j = 0; j < 16; ++j) { const float nxr = ar * xr - ai * xi + fr[j], nxi = ar * xi + ai * xr + fi[j]; xr = nxr; xi = nxi; }
        E[(di * 16 + seg) * 64 + p] = (f32x2v){xr, xi}; }
    LDS_WAIT(); __syncthreads();
    if (tid < 128) { const int di = tid >> 6; const float ar = di ? a16r[1] : a16r[0], ai = di ? a16i[1] : a16i[0]; float xr = 0.f, xi = 0.f;
        for (int seg = 0; seg < 16; ++seg) { XI[(di * 16 + seg) * 64 + p] = (f32x2v){xr, xi}; const f32x2v e = E[(di * 16 + seg) * 64 + p];
            const float nxr = ar * xr - ai * xi + e.x, nxi = ar * xi + ai * xr + e.y; xr = nxr; xi = nxi; } }
    LDS_WAIT(); __syncthreads();
#pragma unroll 1
    for (int jj = 0; jj < 4; ++jj) { const int job = wid + 8 * jj, di = job >> 4, seg = job & 15; float fr[16], fi[16];
#pragma unroll
        for (int j = 0; j < 16; ++j) { const int c = di == 0 ? seg * 16 + j : 255 - (seg * 16 + j); const bf16_t* fp = Fb + (size_t)c * 256 + di * 128 + p; fr[j] = bf2f(fp[0]); fi[j] = bf2f(fp[64]); }
        const float ar = di ? a1r[1] : a1r[0], ai = di ? a1i[1] : a1i[0]; const f32x2v x0 = XI[(di * 16 + seg) * 64 + p]; float xr = x0.x, xi = x0.y;
        bf16_t* xg = XB + ((size_t)g * 1024 + b * 256) * 256 + di * 128 + p;
#pragma unroll
        for (int j = 0; j < 16; ++j) { const int c = di == 0 ? seg * 16 + j : 255 - (seg * 16 + j);
            xg[(size_t)c * 256] = (bf16_t)f2bf(xr); xg[(size_t)c * 256 + 64] = (bf16_t)f2bf(xi);
            const float nxr = ar * xr - ai * xi + fr[j], nxi = ar * xi + ai * xr + fi[j]; xr = nxr; xi = nxi; } }
    __syncthreads();
}
namespace att {
typedef float f32x16 __attribute__((ext_vector_type(16)));
typedef short bf16x8 __attribute__((ext_vector_type(8)));
typedef short v4i16_t __attribute__((ext_vector_type(4)));
typedef LAS const char* lds_cptr;
__device__ __forceinline__ v4i16_t vtr(lds_cptr p) { return __builtin_amdgcn_ds_read_tr16_b64_v4i16((LAS v4i16_t*)p); }
__device__ __forceinline__ void glds16(const void* gsrc, LAS unsigned char* dst_uniform) { __builtin_amdgcn_global_load_lds((const unsigned*)gsrc, (LAS unsigned*)dst_uniform, 16, 0, 0); }
__device__ __forceinline__ unsigned pkbf(float lo, float hi) { return pg8::cvt_pk_bf16(lo, hi); }
__device__ __forceinline__ bf16x8 pack8(const f32x16& p, int base) {
    u32x4 w; w.x = pkbf(p[base + 0], p[base + 1]); w.y = pkbf(p[base + 2], p[base + 3]); w.z = pkbf(p[base + 4], p[base + 5]); w.w = pkbf(p[base + 6], p[base + 7]);
    return __builtin_bit_cast(bf16x8, w);
}
#define ATT_SYNC() do { asm volatile("s_waitcnt vmcnt(0) lgkmcnt(0)" ::: "memory"); __syncthreads(); } while (0)

template <bool MERGE> __device__ __forceinline__ void store_ot(const f32x16& acc, float sc, bf16_t* rowp  , int hi, float wa, float wb) {
    unsigned w[8];
#pragma unroll
    for (int g = 0; g < 4; ++g) { w[2 * g] = pkbf(acc[4 * g] * sc, acc[4 * g + 1] * sc); w[2 * g + 1] = pkbf(acc[4 * g + 2] * sc, acc[4 * g + 3] * sc); }
#pragma unroll
    for (int g = 0; g < 4; g += 2) {
        const auto rx = __builtin_amdgcn_permlane32_swap(w[2 * g], w[2 * g + 2], false, false);
        const auto ry = __builtin_amdgcn_permlane32_swap(w[2 * g + 1], w[2 * g + 3], false, false);
        u32x4 o; o.x = rx[0]; o.y = ry[0]; o.z = rx[1]; o.w = ry[1];
        u32x4* dst = (u32x4*)(rowp + 8 * g + (hi ? 8 : 0));
        if (MERGE) { const u32x4 old = *dst;
#define ATT_MRG(N, O) pkbf(__uint_as_float((O) << 16) * wa + __uint_as_float((N) << 16) * wb, __uint_as_float((O) & 0xffff0000u) * wa + __uint_as_float((N) & 0xffff0000u) * wb)
            o.x = ATT_MRG(o.x, old.x); o.y = ATT_MRG(o.y, old.y); o.z = ATT_MRG(o.z, old.z); o.w = ATT_MRG(o.w, old.w);
#undef ATT_MRG
        }
        *dst = o;
    }
}

__device__ __forceinline__ void xattn_unit(LAS unsigned char* lds, const bf16_t* Qx, const bf16_t* KV, int li, int b, int h, int qb, bf16_t* XO, const int tid) {
    const int lane = tid & 63, wid = __builtin_amdgcn_readfirstlane(tid >> 6), r32 = lane & 31, hi = lane >> 5;
    const size_t tok = (size_t)b * SEQ + qb * 256 + wid * 32 + r32;
    const bf16_t* Kb = KV + (size_t)b * MEMLEN * 8192 + li * 2048 + h * 256;
#pragma unroll 4
    for (int ii = 0; ii < 16; ++ii) { const int i = wid * 16 + ii, key = 2 * i + hi, c = r32 ^ (key & 15);
        glds16(Kb + (size_t)key * 8192 + c * 8, lds + i * 1024); }
    bf16x8 qf[16]; { const bf16_t* qp = Qx + tok * 1024 + h * 256 + hi * 8;
#pragma unroll
        for (int s = 0; s < 16; ++s) qf[s] = *(const bf16x8*)(qp + 16 * s); }
    ATT_SYNC();
    f32x16 S[8];
#pragma unroll
    for (int kt = 0; kt < 8; ++kt) { f32x16 acc = {}; const lds_cptr kp = (lds_cptr)lds + (32 * kt + r32) * 512;
#pragma unroll
        for (int s = 0; s < 16; ++s) { const bf16x8 kf = *(const LAS bf16x8*)(kp + (((2 * s + hi) ^ (r32 & 15)) << 4)); acc = __builtin_amdgcn_mfma_f32_32x32x16_bf16(kf, qf[s], acc, 0, 0, 0); }
        S[kt] = acc; }
    float m = S[0][0];
#pragma unroll
    for (int kt = 0; kt < 8; ++kt)
#pragma unroll
        for (int r = 0; r < 16; ++r) m = fmaxf(m, S[kt][r]);
    m = fmaxf(m, pg8::shx(m, lane, 32));
    float l = 0.f;
#pragma unroll
    for (int kt = 0; kt < 8; ++kt)
#pragma unroll
        for (int r = 0; r < 16; ++r) { const float p = __builtin_amdgcn_exp2f(S[kt][r] - m); S[kt][r] = p; l += p; }
    l += pg8::shx(l, lane, 32);
    const float inv = __builtin_amdgcn_rcpf(l);
    bf16x8 pf[16];
#pragma unroll
    for (int kt = 0; kt < 8; ++kt) { pf[2 * kt] = pack8(S[kt], 0); pf[2 * kt + 1] = pack8(S[kt], 8); }
    ATT_SYNC();
    const bf16_t* Vb = Kb + 1024;
#pragma unroll 4
    for (int ii = 0; ii < 16; ++ii) { const int i = wid * 16 + ii, d0 = i >> 4, ks = i & 15, key = 16 * ks + 8 * hi + ((lane >> 2) & 7), cc = lane & 3;
        glds16(Vb + (size_t)key * 8192 + 32 * d0 + 8 * cc, lds + i * 1024); }
    ATT_SYNC();
    const lds_cptr vb = (lds_cptr)lds + ((lane >> 4) & 1) * 32 + (lane & 3) * 8 + (4 * hi + ((lane & 15) >> 2)) * 64;
    bf16_t* orow = XO + tok * 1024 + h * 256;
#pragma unroll 1
    for (int d0 = 0; d0 < 8; ++d0) { f32x16 acc = {};
#pragma unroll
        for (int ks = 0; ks < 16; ++ks) { const v4i16_t lo = vtr(vb + d0 * 16384 + ks * 1024), hh = vtr(vb + d0 * 16384 + ks * 1024 + 512);
            const bf16x8 vf = {lo[0], lo[1], lo[2], lo[3], hh[0], hh[1], hh[2], hh[3]};
            acc = __builtin_amdgcn_mfma_f32_32x32x16_bf16(vf, pf[ks], acc, 0, 0, 0); }
        store_ot<false>(acc, inv, orow + 32 * d0, hi, 0.f, 0.f); }
    ATT_SYNC();
}

__device__ __forceinline__ void dil_unit(LAS unsigned char* lds, const LAS float* btab, const bf16_t* QKV, int gi, int ldil, int b, int h, int r, int ub, bf16_t* AO, float* lseacc, const int tid) {
    const int lane = tid & 63, wid = __builtin_amdgcn_readfirstlane(tid >> 6), r32 = lane & 31, hi = lane >> 5;
    const int sub_len = SEQ >> ldil, k0 = ub * 256 - 64;
    const size_t tokb = (size_t)b * SEQ + r;
    const bf16_t* base = QKV + h * 128;
#pragma unroll 4
    for (int ii = 0; ii < 12; ++ii) { const int i = wid * 12 + ii, kk = 4 * i + (lane >> 4), c = (lane & 15) ^ (kk & 15); int ki = k0 + kk; ki = ki < 0 ? 0 : (ki >= sub_len ? sub_len - 1 : ki);
        glds16(base + (tokb + ((size_t)ki << ldil)) * 3072 + 1024 + c * 8, lds + i * 1024); }
    const int qi = ub * 256 + wid * 32 + r32; const size_t qtok = tokb + ((size_t)qi << ldil);
    bf16x8 qf[8]; { const bf16_t* qp = base + qtok * 3072 + hi * 8;
#pragma unroll
        for (int s = 0; s < 8; ++s) qf[s] = *(const bf16x8*)(qp + 16 * s); }
    ATT_SYNC();
    f32x16 S[5];
#pragma unroll
    for (int t = 0; t < 5; ++t) { f32x16 acc = {}; const lds_cptr kp = (lds_cptr)lds + (32 * wid + 32 * t + r32) * 256;
#pragma unroll
        for (int s = 0; s < 8; ++s) { const bf16x8 kf = *(const LAS bf16x8*)(kp + (((2 * s + hi) ^ (r32 & 15)) << 4)); acc = __builtin_amdgcn_mfma_f32_32x32x16_bf16(kf, qf[s], acc, 0, 0, 0); }
        S[t] = acc; }
    float m = -3.0e38f;
#pragma unroll
    for (int t = 0; t < 5; ++t)
#pragma unroll
        for (int rr = 0; rr < 16; ++rr) { const int cr = (rr & 3) + 8 * (rr >> 2) + 4 * hi, jk = 32 * t + cr - r32, ki = k0 + 32 * wid + 32 * t + cr;
            float s = S[t][rr] + btab[jk + 32];
            s = ((unsigned)ki < (unsigned)sub_len) ? s : -1e30f;
            S[t][rr] = s; m = fmaxf(m, s); }
    m = fmaxf(m, pg8::shx(m, lane, 32));
    float l = 0.f;
#pragma unroll
    for (int t = 0; t < 5; ++t)
#pragma unroll
        for (int rr = 0; rr < 16; ++rr) { const float p = __builtin_amdgcn_exp2f(S[t][rr] - m); S[t][rr] = p; l += p; }
    l += pg8::shx(l, lane, 32);
    const float inv = __builtin_amdgcn_rcpf(l), lse = m + __builtin_amdgcn_logf(l);
    bf16x8 pf[10];
#pragma unroll
    for (int t = 0; t < 5; ++t) { pf[2 * t] = pack8(S[t], 0); pf[2 * t + 1] = pack8(S[t], 8); }
    ATT_SYNC();
#pragma unroll 4
    for (int ii = 0; ii < 12; ++ii) { const int i = wid * 12 + ii, d0 = i / 24, ks = i % 24, kk = 16 * ks + 8 * hi + ((lane >> 2) & 7), cc = lane & 3; int ki = k0 + kk; ki = ki < 0 ? 0 : (ki >= sub_len ? sub_len - 1 : ki);
        glds16(base + (tokb + ((size_t)ki << ldil)) * 3072 + 2048 + 32 * d0 + 8 * cc, lds + i * 1024); }
    float wa = 0.f, wb = 1.f, ln = lse;
    float* lp = lseacc + qtok * 8 + h;
    if (gi > 0) { const float la = *lp, mx = fmaxf(la, lse); ln = mx + __builtin_amdgcn_logf(__builtin_amdgcn_exp2f(la - mx) + __builtin_amdgcn_exp2f(lse - mx)); wa = __builtin_amdgcn_exp2f(la - ln); wb = __builtin_amdgcn_exp2f(lse - ln); }
    ATT_SYNC();
    const lds_cptr vb = (lds_cptr)lds + ((lane >> 4) & 1) * 32 + (lane & 3) * 8 + (4 * hi + ((lane & 15) >> 2)) * 64 + 2 * wid * 1024;
    bf16_t* orow = AO + qtok * 1024 + h * 128;
#pragma unroll
    for (int d0 = 0; d0 < 4; ++d0) { f32x16 acc = {};
#pragma unroll
        for (int k = 0; k < 10; ++k) { const v4i16_t lo = vtr(vb + (d0 * 24 + k) * 1024), hh = vtr(vb + (d0 * 24 + k) * 1024 + 512);
            const bf16x8 vf = {lo[0], lo[1], lo[2], lo[3], hh[0], hh[1], hh[2], hh[3]};
            acc = __builtin_amdgcn_mfma_f32_32x32x16_bf16(vf, pf[k], acc, 0, 0, 0); }
        if (gi > 0) store_ot<true>(acc, inv, orow + 32 * d0, hi, wa, wb); else store_ot<false>(acc, inv, orow + 32 * d0, hi, 0.f, 0.f); }
    if (hi == 0) *lp = ln;
    ATT_SYNC();
}
#undef ATT_SYNC
}
struct Args { const float* in[27]; float* out; unsigned char* ws; int ph_lo, ph_hi; };
static_assert(sizeof(Args) == 27 * 8 + 8 + 8 + 8, "Args must have no padding");
enum { K_NONE = 0, K_PREP, K_S5STATE, K_SCAN, K_S5OUT, K_GLU, K_KV, K_QKV, K_DIL, K_RES, K_XQ, K_XATTN, K_MLP1 };
__host__ __device__ __forceinline__ int phase_kind(int li, int sub) {
    const bool odd = li & 1;
    switch (sub) {
        case 0: return K_PREP;
        case 1: return odd ? K_QKV : K_S5STATE;
        case 2: return odd ? K_DIL : K_NONE;
        case 3: return odd ? K_QKV : K_NONE;
        case 4: return odd ? K_DIL : K_GLU;
        case 5: return odd ? K_QKV : K_NONE;
        case 6: return odd ? K_DIL : K_NONE;
        case 7: return odd ? K_RES : K_NONE;
        case 8: return K_XQ;
        case 9: return K_NONE;
        case 10: return K_RES;
        case 11: return K_MLP1;
        case 12: return K_RES;
        default: return K_NONE;
    }
}

__global__ void __launch_bounds__(NWAVES * 64, 2) mk_fwd(Args a) {
    extern __shared__ __attribute__((aligned(16))) unsigned char lds_raw[];
    LAS unsigned char* lds = (LAS unsigned char*)lds_raw;
    const int tid0 = threadIdx.x, wave0 = __builtin_amdgcn_readfirstlane(tid0 >> 6);
    const int G = gridDim.x, bx = blockIdx.x, vcu = (G % 8 == 0) ? (bx % 8) * (G / 8) + bx / 8 : bx, NGW = G * NWAVES;
    volatile LAS unsigned* MISC = (volatile LAS unsigned*)(lds + MISC_OFF);
    for (int u = tid0; u < 64; u += NWAVES * 64) MISC[u] = 0u;
    __syncthreads();
    volatile LAS unsigned long long* LP = (volatile LAS unsigned long long*)(lds + MISC_OFF + 256);
    if (tid0 == 0) {
#pragma unroll
        for (int i = 0; i < 27; ++i) LP[i] = (unsigned long long)a.in[i];
        LP[27] = (unsigned long long)a.out; LP[28] = (unsigned long long)a.ws;
    }
    __syncthreads();
#define LDP(i) ((unsigned char*)(GAS unsigned char*)(((unsigned long long)(unsigned)__builtin_amdgcn_readfirstlane((int)(LPv[i] >> 32)) << 32) | (unsigned long long)(unsigned)__builtin_amdgcn_readfirstlane((int)(unsigned)LPv[i])))
#define INP(i) ((const float*)LDP(i))
    XcdBarrier bar = xcd_barrier_post((unsigned*)(a.ws + WS_CTL) + CW_BAR, MISC + 8);
#define out ((float*)LDP(27))
#define ssq ((float*)(wsb + WS_SSQ))
#define rstd_mem ((float*)(wsb + WS_MISC))
#define biasrel ((float*)(wsb + WS_MISC + 16384))
#define hb ((bf16_t*)(wsb + WS_HB))
#define kvall ((bf16_t*)(wsb + WS_KV))
#define memb ((bf16_t*)(wsb + WS_MEMB))
#define T1 ((bf16_t*)(wsb + WS_T1))
#define T2 ((bf16_t*)(wsb + WS_T2))
#define BIG (wsb + WS_BIG)
#define WR (wsb + WS_W)

    bool first = true;
    for (int ph = a.ph_lo; ph < a.ph_hi; ++ph) {
        const int li = ph >> 4, sub = ph & 15, j = li >> 1, kind = phase_kind(li, sub);
        if (kind == K_NONE) continue;
        unsigned lpo = MISC_OFF + 256; asm volatile("" : "+v"(lpo));
        volatile LAS unsigned long long* LPv = (volatile LAS unsigned long long*)(lds + lpo);
        if (!first) { XcdBarrier b2 = bar; b2.bar = (unsigned*)(LDP(28) + WS_CTL) + CW_BAR; xcd_barrier(b2);
        }
        first = false;
        unsigned char* const wsb = LDP(28);
#define PHASE_TID int zero_ = 0; asm volatile("" : "+v"(zero_)); const int tid = wave0 * 64 + (int)__builtin_amdgcn_mbcnt_hi(~0u, __builtin_amdgcn_mbcnt_lo(~0u, (unsigned)zero_)); \
        const int lane = tid & 63, wave = wave0, gw = vcu * NWAVES + wave0; (void)lane; (void)wave; (void)gw
#define SP_INIT const S5In sp{INP(7) + (size_t)j * 8192, INP(8) + (size_t)j * 8192, INP(9) + (size_t)j * 128, INP(10) + (size_t)j * 131072, INP(11) + (size_t)j * 131072, \
                      INP(12) + (size_t)j * 131072, INP(13) + (size_t)j * 131072, INP(14) + (size_t)j * DM, INP(3) + (size_t)li * DM}
        if (kind == K_PREP) { PHASE_TID;
            if (!(li & 1)) { SP_INIT; for (int it = bx; it < 256; it += G) s5_gen(lds, sp, it >> 2, it & 3, (bf16_t*)(WR + W_BST), (bf16_t*)(WR + W_BOUT), tid); }
            LAS float* scr = (LAS float*)(lds + wave * 16384);
            int rot = 0;
            conv_matrix(INP(20) + (size_t)li * DM * DM, DM, DM, DM, MAP_ID, 0, INP(4) + (size_t)li * DM, (bf16_t*)(WR + W_XQ), scr, lane, gw, NGW, rot);
            conv_matrix(INP(22) + (size_t)li * DM * DM, DM, DM, DM, MAP_ID, 0, nullptr, (bf16_t*)(WR + W_XO), scr, lane, gw, NGW, rot);
            conv_matrix(INP(25) + (size_t)li * DM * DFF, DFF, DM, DFF, MAP_ID, 0, INP(6) + (size_t)li * DM, (bf16_t*)(WR + W_1), scr, lane, gw, NGW, rot);
            conv_matrix(INP(26) + (size_t)li * DFF * DM, DM, DFF, DM, MAP_ID, 0, nullptr, (bf16_t*)(WR + W_2), scr, lane, gw, NGW, rot);
            if (!(li & 1)) {
                conv_matrix(INP(15) + (size_t)j * DM * 2048, 2048, DM, 2048, MAP_GLU, 0, nullptr, (bf16_t*)(WR + W_GLU), scr, lane, gw, NGW, rot);
                __syncthreads();
                if (li == 0) { for (int ck = vcu; ck < M / 16; ck += G) unorm_chunk<true>(lds, INP(0), hb, T2, ck, tid); }
                else { for (int ck = vcu; ck < M / 16; ck += G) unorm_chunk<false>(lds, nullptr, hb, T2, ck, tid); }
            } else {
                for (int gi = 0; gi < 3; ++gi)
                    conv_matrix(INP(16) + (size_t)j * DM * 9216, 9216, DM, 3072, MAP_QKV, gi, INP(3) + (size_t)li * DM, (bf16_t*)(WR + W_QKV) + (size_t)gi * 3072 * DM, scr, lane, gw, NGW, rot);
                conv_matrix(INP(17) + (size_t)j * DM * DM, DM, DM, DM, MAP_ID, 0, nullptr, (bf16_t*)(WR + W_AO), scr, lane, gw, NGW, rot);
            }
            if (li == 0) {
                for (int l = 0; l < DEPTH; ++l)
                    conv_matrix(INP(21) + (size_t)l * DM * 2048, 2048, DM, 2048, MAP_ID, 0, INP(5) + (size_t)l * DM, (bf16_t*)(BIG + BIG_WKV) + (size_t)l * 2048 * DM, scr, lane, gw, NGW, rot);
                for (int m = gw; m < MROWS; m += NGW) { const float r = row_f32_to_bf16(INP(1) + (size_t)m * DM, memb + (size_t)m * DM, nullptr, lane); if (lane == 0) rstd_mem[m] = r; }
                if (bx == 0) for (int idx = tid; idx < 24 * 129; idx += NWAVES * 64) {
                    const int gh = idx / 129, jk = idx % 129, gi = gh / 8, dil = gi == 0 ? 1 : (gi == 1 ? 4 : 16), rel = (jk - 64) * dil, n = rel < 0 ? -rel : rel;
                    int bucket = rel > 0 ? 16 : 0;
                    if (n < 8) bucket += n; else { int large = 8 + (int)(logf((float)n / 8.0f) / logf(128.0f) * 8.0f); if (large > 15) large = 15; bucket += large; }
                    biasrel[idx] = INP(2)[bucket * 24 + gh] * LOG2E; }
            }
            __syncthreads();
        }
        if ((kind == K_XQ || (kind == K_S5STATE && li == 0))) { PHASE_TID;
            const bool kv = kind != K_XQ;
            const pg8::Gemm g{kv ? (const bf16_t*)(BIG + BIG_WKV) : (const bf16_t*)(WR + W_XQ), kv ? MROWS : M, kv ? 8192 : DM, DM};
            const pg8::ASrcLinear AS{kv ? (const char*)memb : (const char*)hb, DM};
            pg8::StaticOrder S; S.init(g.M, g.N, G, bx);
            const pg8::EpiHeadNorm<1> E{kv ? nullptr : ssq, rstd_mem, kv ? INP(24) : INP(23) + (size_t)li * 256, nullptr, kv ? kvall : T2, kv ? 8192 : DM, kv ? 1 : 0, QSCALE_X, 0};
            pg8::gemm_phase(lds, g, AS, S, E, tid);
            if (!kv) { pg8::Unit u;
                for (int i = 0; S.next(i, u); ++i) att::xattn_unit(lds, T2, kvall, li, u.pm >> 4, u.pn, u.pm & 15, T1, tid); }
        }
        if (kind == K_S5STATE) { PHASE_TID;
            pg8::StaticOrder S; S.init(1024, 16384, G, bx);
            { const pg8::Gemm g{(const bf16_t*)(WR + W_BST), 1024, 16384, 256}; const pg8::ASrcChunk AS{(const char*)T2, 0};
              const pg8::EpiS5State E{(bf16_t*)(BIG + BIG_F)};
              pg8::gemm_phase(lds, g, AS, S, E, tid); }
            { SP_INIT; pg8::Unit u; for (int i = 0; S.next(i, u); ++i) s5_scan_bg(lds, sp, (const bf16_t*)(BIG + BIG_F), (bf16_t*)(BIG + BIG_XB), u.pm, u.pn, tid); }
            asm volatile("s_waitcnt vmcnt(0)" ::: "memory"); __syncthreads();
            { const pg8::Gemm g{(const bf16_t*)(WR + W_BOUT), 1024, 16384, 512}; const pg8::ASrcChunk AS{(const char*)T2, (long)(WS_BIG + BIG_XB) - (long)WS_T2};
              const pg8::EpiS5Out E{T1};
              pg8::gemm_phase(lds, g, AS, S, E, tid); }
        } else if (kind == K_GLU) { PHASE_TID;
            const pg8::Gemm g{(const bf16_t*)(WR + W_GLU), M, 2048, DM}; const pg8::ASrcLinear AS{(const char*)T1, DM};
            pg8::StaticOrder S; S.init(M, 2048, G, bx);
            const pg8::EpiGlu E{hb, ssq};
            pg8::gemm_phase(lds, g, AS, S, E, tid);
        } else if (kind == K_QKV) { PHASE_TID;
            const int gi = (sub - 1) >> 1;
            const pg8::Gemm g{(const bf16_t*)(WR + W_QKV) + (size_t)gi * 3072 * DM, M, 3072, DM}; const pg8::ASrcLinear AS{(const char*)hb, DM};
            pg8::StaticOrder S; S.init(M, 3072, G, bx);
            const pg8::EpiHeadNorm<2> E{ssq, nullptr, INP(18) + (size_t)j * 128, INP(19) + (size_t)j * 128, (bf16_t*)BIG, 3072, 2, QSCALE_DIL, 0};
            pg8::gemm_phase(lds, g, AS, S, E, tid);
        } else if (kind == K_RES) { PHASE_TID;
            const bf16_t* Bt = sub == 7 ? (const bf16_t*)(WR + W_AO) : (sub == 10 ? (const bf16_t*)(WR + W_XO) : (const bf16_t*)(WR + W_2));
            const int K = sub == 12 ? DFF : DM;
            const pg8::Gemm g{Bt, M, DM, K}; const pg8::ASrcLinear AS{sub == 12 ? (const char*)BIG : (const char*)T1, K};
            pg8::StaticOrder S; S.init(M, DM, G, bx);
            const pg8::EpiRes E{hb, ssq, (li == DEPTH - 1 && sub == 12) ? out : nullptr};
            pg8::gemm_phase(lds, g, AS, S, E, tid);
        } else if (kind == K_MLP1) { PHASE_TID;
            const pg8::Gemm g{(const bf16_t*)(WR + W_1), M, DFF, DM}; const pg8::ASrcLinear AS{(const char*)hb, DM};
            pg8::StaticOrder S; S.init(M, DFF, G, bx);
            { const pg8::EpiMlp1 E{ssq, (bf16_t*)BIG};
            pg8::gemm_phase(lds, g, AS, S, E, tid); }
        }
        else if (kind == K_DIL) { PHASE_TID;
            const int gi = (sub - 2) >> 1, ldil = 2 * gi;
            LAS float* btab = (LAS float*)(lds + RING_BYTES);
            for (int u = vcu; u < 512; u += G) { const int x = u & 15, bh = u >> 4, h = bh & 7;
                if (tid < 192) { const int jk = tid - 32; btab[tid] = (jk >= 0 && jk <= 128) ? biasrel[(gi * 8 + h) * 129 + jk] : -1e30f; }
                att::dil_unit(lds, btab, (const bf16_t*)BIG, gi, ldil, bh >> 3, h, x & ((1 << ldil) - 1), x >> ldil, T1, (float*)(wsb + WS_MISC + 65536), tid); }
        }
    }
}
#undef out
#undef ssq
#undef rstd_mem
#undef biasrel
#undef hb
#undef kvall
#undef memb
#undef T1
#undef T2
#undef BIG
#undef WR
#undef SP_INIT
#undef PHASE_TID
#undef LDP
#undef INP
extern "C" void kernel_launch(void* const* d_in, const int* in_sizes, int n_in, void* d_out, int out_size, void* d_ws, size_t ws_size, hipStream_t stream) {
    static int grid = 0;
    if (grid == 0) {
        if (n_in != 27 || ws_size < WS_END || in_sizes[0] != M * DM || out_size != M * DM) { fprintf(stderr, "kernel_launch: unexpected n_in %d / ws %zu\n", n_in, ws_size); grid = -1; return; }
        int dev = 0, cus = 0;
        if (hipGetDevice(&dev) != hipSuccess || hipDeviceGetAttribute(&cus, hipDeviceAttributeMultiprocessorCount, dev) != hipSuccess) { grid = -1; return; }
        if (hipFuncSetAttribute((const void*)mk_fwd, hipFuncAttributeMaxDynamicSharedMemorySize, LDS_BYTES) != hipSuccess) { fprintf(stderr, "kernel_launch: hipFuncSetAttribute failed\n"); grid = -1; return; }
        grid = cus;
    }
    if (grid < 0) return;
    float* out = (float*)d_out; unsigned char* ws = (unsigned char*)d_ws;
    Args a{};
    for (int i = 0; i < 27; ++i) a.in[i] = (const float*)d_in[i];
    a.out = out; a.ws = ws;
    auto fast = [&](int lo, int hi) {
        (void)hipMemsetAsync(ws + WS_CTL, 0, 65536, stream);
        a.ph_lo = lo; a.ph_hi = hi;
        hipLaunchKernelGGL(mk_fwd, dim3(grid), dim3(NWAVES * 64), LDS_BYTES, stream, a);
    };

    fast(0, DEPTH * 16);
}
```

```cpp
#include <hip/hip_runtime.h>
#include <cstdint>
#include <cstdio>

typedef unsigned short bf16_t;
typedef unsigned u32x4 __attribute__((ext_vector_type(4)));
typedef unsigned u32x2 __attribute__((ext_vector_type(2)));
typedef float f32x4 __attribute__((ext_vector_type(4)));

constexpr int BATCH = 4, SEQ = 4096, DM = 1024, M = BATCH * SEQ, DEPTH = 4;
constexpr int MEMLEN = 256, MROWS = BATCH * MEMLEN;
constexpr int DFF = 4096;
constexpr float EPS = 1e-6f;
constexpr float LOG2E = 1.4426950408889634f;
constexpr float QSCALE_DIL = 0.08838834764831845f * LOG2E;
constexpr float QSCALE_X = 0.0625f * LOG2E;

constexpr size_t MiB = 1u << 20;
constexpr size_t WS_CTL = 0;
constexpr size_t WS_MISC = 1 * MiB;
constexpr size_t WS_SSQ = 2 * MiB;
constexpr size_t WS_HB = 4 * MiB;
constexpr size_t WS_KV = 36 * MiB;
constexpr size_t WS_MEMB = 52 * MiB;
constexpr size_t WS_T1 = 54 * MiB;
constexpr size_t WS_T2 = 86 * MiB;
constexpr size_t WS_BIG = 118 * MiB;
constexpr size_t WS_W = 246 * MiB;
constexpr size_t WS_END = 342 * MiB;

__device__ __forceinline__ float bf2f(bf16_t v) { return __uint_as_float((unsigned)v << 16); }
__device__ __forceinline__ unsigned f2bf(float f) { unsigned u = __float_as_uint(f); return (u + 0x7fffu + ((u >> 16) & 1u)) >> 16; }
__device__ __forceinline__ unsigned pk2(float lo, float hi) { return f2bf(lo) | (f2bf(hi) << 16); }

namespace pg8 {
#define PG8_LAS __attribute__((address_space(3)))
typedef short bf16x8 __attribute__((ext_vector_type(8)));
constexpr int BM = 256, BK = 64, HALF = 128, HTB = HALF * BK * 2  , STAGE_BYTES = 8 * HTB, NXCD = 8, WGM = 8;
constexpr int XCH_OFF = STAGE_BYTES;

__host__ __device__ __forceinline__ int lds_byte(int r, int c) { const int st = (r >> 4) * 2 + (c >> 5), rr = r & 15, cc = c & 31, ob = rr * 64 + cc * 2; return st * 1024 + (ob ^ (((ob >> 9) & 1) << 5)); }
__host__ __device__ __forceinline__ void stage_rc(int b, int& R, int& C) { const int st = b / 1024, sb = b % 1024, swz = sb ^ (((sb >> 9) & 1) << 5); R = (st >> 1) * 16 + swz / 64; C = (st & 1) * 32 + (swz % 64) / 2; }
__host__ __device__ __forceinline__ int perm32(int rho) { const int n = rho >> 4, i = rho & 15; return 8 * (i >> 2) + 4 * n + (i & 3); }

struct Unit { int pm, pn; };
struct StaticOrder {
    int nM, nN, nwg, G, c;
    __device__ void init(int M_, int N_, int G_, int c_) { nM = M_ / BM; nN = N_ / BM; nwg = nM * nN; G = G_; c = c_; }
    __device__ bool next(int i, Unit& u) const {
        const long L = (long)i * G + c; if (L >= nwg) return false;
        int wgid = (int)L; { const int q = nwg / NXCD, r = nwg % NXCD, xcd = wgid % NXCD, off = wgid / NXCD; wgid = (xcd < r ? xcd * (q + 1) : r * (q + 1) + (xcd - r) * q) + off; }
        const int nig = WGM * nN, gid = wgid / nig, fm = gid * WGM, gsz = (nM - fm) < WGM ? (nM - fm) : WGM;
        u.pm = fm + ((wgid % nig) % gsz); u.pn = (wgid % nig) / gsz; return true;
    }
};

struct ASrcLinear {
    const char* A; int K;
    __device__ __forceinline__ unsigned voff(int R, int C) const { return (unsigned)(R * K + C) * 2u; }
    __device__ __forceinline__ size_t hstep() const { return (size_t)HALF * K * 2; }
    __device__ __forceinline__ const char* tile(const Unit& u, int t) const { return A + (size_t)u.pm * 2 * hstep() + (size_t)t * (BK * 2); }
};
struct ASrcChunk {
    const char* U; long xoff;
    __device__ __forceinline__ unsigned voff(int R, int C) const { return (unsigned)(R * 256 + C) * 2u; }
    __device__ __forceinline__ size_t hstep() const { return (size_t)HALF * 512; }
    __device__ __forceinline__ const char* tile(const Unit& u, int t) const { return U + (long)(t >> 2) * xoff + (size_t)u.pn * (1024 * 512) + (size_t)u.pm * 2 * hstep() + (size_t)(t & 3) * (BK * 2); }
};
struct Gemm { const bf16_t* Bt; int M, N, K; };

__device__ __forceinline__ unsigned cvt_pk_bf16(float lo, float hi) { unsigned r; asm volatile("v_cvt_pk_bf16_f32 %0, %1, %2" : "=v"(r) : "v"(lo), "v"(hi)); return r; }
__device__ __forceinline__ float shx(float v, int lane, int mask) { return __builtin_bit_cast(float, __builtin_amdgcn_ds_bpermute((lane ^ mask) << 2, __builtin_bit_cast(int, v))); }
#define PG8_XBAR() do { asm volatile("s_waitcnt lgkmcnt(0)" ::: "memory"); __builtin_amdgcn_s_barrier(); asm volatile("" ::: "memory"); } while (0)

constexpr int RSTD_OFF = STAGE_BYTES + 8192 + 1024;
__device__ __forceinline__ void rstd_panel_to_lds(PG8_LAS unsigned char* lds, const float* ssq, int pm, int tid) {
    const int row = tid >> 1, hf = tid & 1, lane = tid & 63;
    const f32x4* p = (const f32x4*)(ssq + (size_t)(pm * BM + row) * 32 + hf * 16);
    const f32x4 a = p[0], b = p[1], c = p[2], d = p[3];
    float s = (((a.x + a.y) + (a.z + a.w)) + ((b.x + b.y) + (b.z + b.w))) + (((c.x + c.y) + (c.z + c.w)) + ((d.x + d.y) + (d.z + d.w)));
    s += shx(s, lane, 1);
    if (hf == 0) ((PG8_LAS float*)(lds + RSTD_OFF))[row] = rsqrtf(s * (1.0f / 1024.f) + 1e-6f);
}
__device__ __forceinline__ void rstd_from_lds(PG8_LAS unsigned char* lds, int wr, int fr, float (&rs)[2][4]) {
#pragma unroll
    for (int ai = 0; ai < 2; ++ai)
#pragma unroll
        for (int m = 0; m < 4; ++m) rs[ai][m] = ((const PG8_LAS float*)(lds + RSTD_OFF))[ai * HALF + wr * 64 + m * 16 + fr];
}
typedef f32x4 AccT[2][2][4][2];

__device__ __forceinline__ f32x4 bf_lo4(unsigned a, unsigned b) { return (f32x4){__uint_as_float(a << 16), __uint_as_float(a & 0xffff0000u), __uint_as_float(b << 16), __uint_as_float(b & 0xffff0000u)}; }
struct EpiRes {
    static constexpr bool PERM = true, AFTER_DRAIN = false;
    bf16_t* hb; float* ssq; float* fout;
    __device__ __forceinline__ void prologue(const Unit&, PG8_LAS unsigned char*, int) const {}
    __device__ __forceinline__ void operator()(AccT& acc, const Unit& u, int wr, int wc, int fr, int fq, PG8_LAS unsigned char*) const {
        const int col0 = u.pn * BM + wc * 32 + 8 * fq, lane = fr + 16 * fq;
        const int row0 = u.pm * BM + wr * 64 + fr;
        const unsigned e0 = (unsigned)row0 * 1024u + (unsigned)col0;
        const char* hbc = (const char*)hb;
        u32x4 bs[2][4][2];
#pragma unroll
        for (int ai = 0; ai < 2; ++ai)
#pragma unroll
            for (int m = 0; m < 4; ++m) { const unsigned e = e0 + (unsigned)((ai * HALF + m * 16) * 1024);
                bs[ai][m][0] = *(const u32x4*)(hbc + (e * 2u)); bs[ai][m][1] = *(const u32x4*)(hbc + ((e + HALF) * 2u)); }
#pragma unroll
        for (int ai = 0; ai < 2; ++ai) {
#pragma unroll
            for (int m = 0; m < 4; ++m) { const int row = row0 + ai * HALF + m * 16; const unsigned e = e0 + (unsigned)((ai * HALF + m * 16) * 1024);
#pragma unroll
                for (int bj = 0; bj < 2; ++bj) { const u32x4 bb = bs[ai][m][bj];
                    const f32x4 v0 = acc[ai][bj][m][0] + bf_lo4(bb.x, bb.y), v1 = acc[ai][bj][m][1] + bf_lo4(bb.z, bb.w);
                    u32x4 w; w.x = cvt_pk_bf16(v0.x, v0.y); w.y = cvt_pk_bf16(v0.z, v0.w); w.z = cvt_pk_bf16(v1.x, v1.y); w.w = cvt_pk_bf16(v1.z, v1.w);
                    if (fout) { float* fo = (float*)((char*)fout + (size_t)(e + bj * HALF) * 4u); *(f32x4*)fo = v0; *(f32x4*)(fo + 4) = v1; }
                    else {
                        *(u32x4*)((char*)hb + ((e + bj * HALF) * 2u)) = w;
                        float ss = ((v0.x * v0.x + v0.y * v0.y) + (v0.z * v0.z + v0.w * v0.w)) + ((v1.x * v1.x + v1.y * v1.y) + (v1.z * v1.z + v1.w * v1.w));
                        ss += shx(ss, lane, 16); ss += shx(ss, lane, 32);
                        if (fq == 0) ssq[(size_t)row * 32 + u.pn * 8 + bj * 4 + wc] = ss; } } }
            asm volatile("" ::: "memory"); }
    }
};
struct EpiGlu {
    static constexpr bool PERM = true, AFTER_DRAIN = false;
    bf16_t* hb; float* ssq;
    __device__ __forceinline__ void prologue(const Unit&, PG8_LAS unsigned char*, int) const {}
    __device__ __forceinline__ void operator()(AccT& acc, const Unit& u, int wr, int wc, int fr, int fq, PG8_LAS unsigned char*) const {
        const int col0 = u.pn * HALF + wc * 32 + 8 * fq, lane = fr + 16 * fq;
        u32x4 bs[2][4];
#pragma unroll
        for (int ai = 0; ai < 2; ++ai)
#pragma unroll
            for (int m = 0; m < 4; ++m) bs[ai][m] = *(const u32x4*)(hb + (size_t)(u.pm * BM + ai * HALF + wr * 64 + m * 16 + fr) * 1024 + col0);
#pragma unroll
        for (int ai = 0; ai < 2; ++ai)
#pragma unroll
            for (int m = 0; m < 4; ++m) { const int row = u.pm * BM + ai * HALF + wr * 64 + m * 16 + fr; const size_t off = (size_t)row * 1024 + col0;
                const u32x4 bb = bs[ai][m];
                f32x4 v0 = bf_lo4(bb.x, bb.y), v1 = bf_lo4(bb.z, bb.w);
                const f32x4 a0 = acc[ai][0][m][0], a1 = acc[ai][0][m][1], g0 = acc[ai][1][m][0], g1 = acc[ai][1][m][1];
#pragma unroll
                for (int j = 0; j < 4; ++j) { v0[j] += a0[j] * __builtin_amdgcn_rcpf(1.f + __builtin_amdgcn_exp2f(-1.4426950408889634f * g0[j]));
                                              v1[j] += a1[j] * __builtin_amdgcn_rcpf(1.f + __builtin_amdgcn_exp2f(-1.4426950408889634f * g1[j])); }
                u32x4 w; w.x = cvt_pk_bf16(v0.x, v0.y); w.y = cvt_pk_bf16(v0.z, v0.w); w.z = cvt_pk_bf16(v1.x, v1.y); w.w = cvt_pk_bf16(v1.z, v1.w);
                *(u32x4*)(hb + off) = w;
                float ss = ((v0.x * v0.x + v0.y * v0.y) + (v0.z * v0.z + v0.w * v0.w)) + ((v1.x * v1.x + v1.y * v1.y) + (v1.z * v1.z + v1.w * v1.w));
                ss += shx(ss, lane, 16); ss += shx(ss, lane, 32);
                if (fq == 0) ssq[(size_t)row * 32 + u.pn * 4 + wc] = ss; }
    }
};
struct EpiMlp1 {
    static constexpr bool PERM = true, AFTER_DRAIN = false;
    const float* ssq; bf16_t* out;
    __device__ __forceinline__ void prologue(const Unit& u, PG8_LAS unsigned char* lds, int tid) const { rstd_panel_to_lds(lds, ssq, u.pm, tid); }
    __device__ __forceinline__ void operator()(AccT& acc, const Unit& u, int wr, int wc, int fr, int fq, PG8_LAS unsigned char* lds) const {
        const int rowbase = u.pm * BM + wr * 64 + fr, col0 = u.pn * BM + wc * 32 + 8 * fq;
        float rs[2][4]; rstd_from_lds(lds, wr, fr, rs);
#pragma unroll
        for (int ai = 0; ai < 2; ++ai)
#pragma unroll
            for (int m = 0; m < 4; ++m) { bf16_t* rowp = out + (size_t)(rowbase + ai * HALF + m * 16) * 4096 + col0; const float r = rs[ai][m];
#pragma unroll
                for (int bj = 0; bj < 2; ++bj) { f32x4 v0 = acc[ai][bj][m][0] * r, v1 = acc[ai][bj][m][1] * r;
#pragma unroll
                    for (int j = 0; j < 4; ++j) { v0[j] = fmaxf(v0[j], 0.f); v0[j] *= v0[j]; v1[j] = fmaxf(v1[j], 0.f); v1[j] *= v1[j]; }
                    u32x4 w; w.x = cvt_pk_bf16(v0[0], v0[1]); w.y = cvt_pk_bf16(v0[2], v0[3]); w.z = cvt_pk_bf16(v1[0], v1[1]); w.w = cvt_pk_bf16(v1[2], v1[3]);
                    *(u32x4*)(rowp + bj * HALF) = w; } }
    }
};
template <int NSEG> struct EpiHeadNorm {
    static constexpr bool PERM = true, AFTER_DRAIN = false;
    const float* ssq;
    const float* rowscale;
    const float* gain0; const float* gain1;
    bf16_t* out; int ldc; int mode; float sc0; int pad;
    __device__ __forceinline__ void prologue(const Unit& u, PG8_LAS unsigned char* lds, int tid) const { if (ssq) rstd_panel_to_lds(lds, ssq, u.pm, tid); }
    __device__ __forceinline__ void operator()(AccT& acc, const Unit& u, int wr, int wc, int fr, int fq, PG8_LAS unsigned char* lds) const {
        const int rowbase = u.pm * BM + wr * 64 + fr, col0 = u.pn * BM + wc * 32 + 8 * fq;
        bool normed; const float* g; float psc = 1.f;
        if (mode == 0) { normed = true; g = gain0; psc = sc0; }
        else if (mode == 1) { normed = (u.pn & 7) < 4; g = gain0 + 256 * (u.pn >> 3); }
        else { const int which = u.pn >> 2; normed = which < 2; g = which == 0 ? gain0 : gain1; psc = which == 0 ? sc0 : 1.f; }
        f32x4 gv[2][2];
#pragma unroll
        for (int bj = 0; bj < 2; ++bj)
#pragma unroll
            for (int n = 0; n < 2; ++n) gv[bj][n] = normed ? *(const f32x4*)(g + (NSEG == 1 ? bj * HALF : 0) + wc * 32 + 8 * fq + 4 * n) : (f32x4){1.f, 1.f, 1.f, 1.f};
        float rs[2][4];
        if (ssq) rstd_from_lds(lds, wr, fr, rs);
        else {
#pragma unroll
            for (int ai = 0; ai < 2; ++ai)
#pragma unroll
                for (int m = 0; m < 4; ++m) rs[ai][m] = rowscale[rowbase + ai * HALF + m * 16];
        }
        float rn[2][4][2];
        if (normed) {
            PG8_LAS float* P = (PG8_LAS float*)(lds + XCH_OFF);
#pragma unroll
            for (int ai = 0; ai < 2; ++ai)
#pragma unroll
                for (int m = 0; m < 4; ++m) { float s[2];
#pragma unroll
                    for (int bj = 0; bj < 2; ++bj) { const f32x4 a = acc[ai][bj][m][0], b = acc[ai][bj][m][1];
                        s[bj] = ((a.x * a.x + a.y * a.y) + (a.z * a.z + a.w * a.w)) + ((b.x * b.x + b.y * b.y) + (b.z * b.z + b.w * b.w)); }
                    if (NSEG == 1) { s[0] += s[1]; s[1] = 0.f; }
#pragma unroll
                    for (int sg = 0; sg < NSEG; ++sg) { float t = s[sg]; t += shx(t, fr + 16 * fq, 16); t += shx(t, fr + 16 * fq, 32);
                        if (fq == 0) P[((ai * HALF + wr * 64 + m * 16 + fr) * 2 + sg) * 4 + wc] = t; } }
            PG8_XBAR();
#pragma unroll
            for (int ai = 0; ai < 2; ++ai)
#pragma unroll
                for (int m = 0; m < 4; ++m)
#pragma unroll
                    for (int sg = 0; sg < NSEG; ++sg) { const f32x4 t = *(const PG8_LAS f32x4*)(P + ((ai * HALF + wr * 64 + m * 16 + fr) * 2 + sg) * 4);
                        const float r0 = rs[ai][m]; rn[ai][m][sg] = rsqrtf(((t.x + t.y) + (t.z + t.w)) * (r0 * r0) * (NSEG == 1 ? 1.0f / 256.f : 1.0f / 128.f) + 1e-6f) * (psc * r0); }
        }
#pragma unroll
        for (int ai = 0; ai < 2; ++ai)
#pragma unroll
            for (int m = 0; m < 4; ++m) { bf16_t* rowp = out + (size_t)(rowbase + ai * HALF + m * 16) * ldc + col0;
#pragma unroll
                for (int bj = 0; bj < 2; ++bj) { const float r = normed ? rn[ai][m][NSEG == 1 ? 0 : bj] : rs[ai][m];
                    const f32x4 v0 = acc[ai][bj][m][0] * gv[bj][0] * r, v1 = acc[ai][bj][m][1] * gv[bj][1] * r;
                    u32x4 w; w.x = cvt_pk_bf16(v0[0], v0[1]); w.y = cvt_pk_bf16(v0[2], v0[3]); w.z = cvt_pk_bf16(v1[0], v1[1]); w.w = cvt_pk_bf16(v1[2], v1[3]);
                    *(u32x4*)(rowp + bj * HALF) = w; } }
    }
};
struct EpiS5State {
    static constexpr bool PERM = true, AFTER_DRAIN = false;
    bf16_t* F;
    __device__ __forceinline__ void prologue(const Unit&, PG8_LAS unsigned char*, int) const {}
    __device__ __forceinline__ void operator()(AccT& acc, const Unit& u, int wr, int wc, int fr, int fq, PG8_LAS unsigned char*) const {
        const int col0 = wc * 32 + 8 * fq;
#pragma unroll
        for (int ai = 0; ai < 2; ++ai)
#pragma unroll
            for (int m = 0; m < 4; ++m) { bf16_t* rowp = F + ((size_t)u.pn * 1024 + u.pm * BM + ai * HALF + wr * 64 + m * 16 + fr) * 256 + col0;
#pragma unroll
                for (int bj = 0; bj < 2; ++bj) { const f32x4 v0 = acc[ai][bj][m][0], v1 = acc[ai][bj][m][1];
                    u32x4 w; w.x = cvt_pk_bf16(v0[0], v0[1]); w.y = cvt_pk_bf16(v0[2], v0[3]); w.z = cvt_pk_bf16(v1[0], v1[1]); w.w = cvt_pk_bf16(v1[2], v1[3]);
                    *(u32x4*)(rowp + bj * HALF) = w; } }
    }
};
__device__ __forceinline__ float gelu_tanh_fast(float x) {
    const float z2 = 2.302208198f * (x + 0.044715f * x * x * x);
    const float e = __builtin_amdgcn_exp2f(z2);
    return x - x * __builtin_amdgcn_rcpf(1.f + e);
}
struct EpiS5Out {
    static constexpr bool PERM = true, AFTER_DRAIN = false;
    bf16_t* G;
    __device__ __forceinline__ void prologue(const Unit&, PG8_LAS unsigned char*, int) const {}
    __device__ __forceinline__ void operator()(AccT& acc, const Unit& u, int wr, int wc, int fr, int fq, PG8_LAS unsigned char*) const {
#pragma unroll
        for (int ai = 0; ai < 2; ++ai)
#pragma unroll
            for (int m = 0; m < 4; ++m) { const int crow = u.pm * BM + ai * HALF + wr * 64 + m * 16 + fr;
#pragma unroll
                for (int bj = 0; bj < 2; ++bj) { const int c = bj * HALF + wc * 32 + 8 * fq, s = c >> 4, ch0 = c & 15;
                    f32x4 v0 = acc[ai][bj][m][0], v1 = acc[ai][bj][m][1];
#pragma unroll
                    for (int j = 0; j < 4; ++j) { v0[j] = gelu_tanh_fast(v0[j]); v1[j] = gelu_tanh_fast(v1[j]); }
                    u32x4 w; w.x = cvt_pk_bf16(v0[0], v0[1]); w.y = cvt_pk_bf16(v0[2], v0[3]); w.z = cvt_pk_bf16(v1[0], v1[1]); w.w = cvt_pk_bf16(v1[2], v1[3]);
                    *(u32x4*)(G + ((size_t)crow * 16 + s) * 1024 + u.pn * 16 + ch0) = w; } }
    }
};

struct NoHook { __device__ __forceinline__ void operator()() const {} };
template <class Epi, class ASrc, class Hook = NoHook>
__device__ __forceinline__ void gemm_phase(PG8_LAS unsigned char* lds, const Gemm g, const ASrc AS, const StaticOrder& S, const Epi& E, const int tid  ,
                                           const char* warm = nullptr  , int wK = 0, const Hook& hook = Hook(),
                                           const char* wmat = nullptr  , unsigned wbytes = 0, unsigned gtid = 0  ) {
    const int wid = __builtin_amdgcn_readfirstlane(tid >> 6), lane = tid & 63, wr = wid >> 2, wc = wid & 3, fr = lane & 15, fq = lane >> 4;
    const int K = g.K, nt = K / BK;
    unsigned voffA[2], voffB[2];
#pragma unroll
    for (int i = 0; i < 2; ++i) { int R, C; stage_rc(tid * 16 + i * 8192, R, C); const int Rb = Epi::PERM ? ((R & ~31) + perm32(R & 31)) : R;
        voffA[i] = AS.voff(R, C); voffB[i] = (unsigned)(Rb * K + C) * 2u; }
    const size_t kstep = (size_t)(BK * 2);
    const size_t hstepB = (size_t)HALF * K * 2, hstepA = AS.hstep();
    const unsigned ldsw = (unsigned)wid * 1024u;
    const int aoff = lds_byte(wr * 64 + fr, fq * 8), boff = lds_byte(wc * 32 + fr, fq * 8);
#define PG8_SA(b, h) (((b) * 2 + (h)) * HTB)
#define PG8_SB(b, h) ((4 + (b) * 2 + (h)) * HTB)
#define PG8_STAGE(bufoff, gbase, voff) do { _Pragma("unroll") for (int _i = 0; _i < 2; ++_i) \
        __builtin_amdgcn_global_load_lds((const unsigned*)((const char*)(gbase) + (voff)[_i]), (PG8_LAS unsigned*)(lds + (bufoff) + ldsw + _i * 8192), 16, 0, 0); } while (0)
#define PG8_LDA(dst, b, h) do { _Pragma("unroll") for (int m = 0; m < 4; ++m) _Pragma("unroll") for (int k = 0; k < 2; ++k) dst[m][k] = *(const PG8_LAS bf16x8*)(lds + PG8_SA(b, h) + aoff + m * 2048 + k * 1024); } while (0)
#define PG8_LDB(dst, b, h) do { _Pragma("unroll") for (int n = 0; n < 2; ++n) _Pragma("unroll") for (int k = 0; k < 2; ++k) dst[n][k] = *(const PG8_LAS bf16x8*)(lds + PG8_SB(b, h) + boff + n * 2048 + k * 1024); } while (0)
#define PG8_MMA(ai, bj, At, Bt) do { __builtin_amdgcn_s_setprio(1); _Pragma("unroll") for (int m = 0; m < 4; ++m) _Pragma("unroll") for (int n = 0; n < 2; ++n) _Pragma("unroll") for (int k = 0; k < 2; ++k) \
        acc[ai][bj][m][n] = __builtin_amdgcn_mfma_f32_16x16x32_bf16(Bt[n][k], At[m][k], acc[ai][bj][m][n], 0, 0, 0); __builtin_amdgcn_s_setprio(0); } while (0)
#define PG8_WAIT_V(n) asm volatile("s_waitcnt vmcnt(" #n ")" ::: "memory")
#define PG8_WAIT_L(n) asm volatile("s_waitcnt lgkmcnt(" #n ")" ::: "memory")
#define PG8_BAR __builtin_amdgcn_s_barrier()
#define PG8_SCHED __builtin_amdgcn_sched_barrier(0)
    Unit cur, nxt; int ui = 0; unsigned warmv = 0u, warmm = 0u;
    if (!S.next(0, cur)) return;
    AccT acc;
#pragma unroll
    for (int a = 0; a < 2; ++a)
#pragma unroll
        for (int b = 0; b < 2; ++b)
#pragma unroll
            for (int m = 0; m < 4; ++m)
#pragma unroll
                for (int n = 0; n < 2; ++n) acc[a][b][m][n] = (f32x4){0.f, 0.f, 0.f, 0.f};
    bf16x8 At[4][2], B0[2][2], B1[2][2];
    const char* cB = (const char*)g.Bt + (size_t)cur.pn * 2 * hstepB;
    { const char* cA0 = AS.tile(cur, 0); const char* cA1 = AS.tile(cur, 1);
      PG8_STAGE(PG8_SB(0, 0), cB, voffB); PG8_STAGE(PG8_SB(0, 1), cB + hstepB, voffB); PG8_STAGE(PG8_SA(0, 0), cA0, voffA); PG8_STAGE(PG8_SA(0, 1), cA0 + hstepA, voffA);
      PG8_STAGE(PG8_SB(1, 0), cB + kstep, voffB); PG8_STAGE(PG8_SA(1, 0), cA1, voffA); PG8_STAGE(PG8_SB(1, 1), cB + hstepB + kstep, voffB);
      E.prologue(cur, lds, tid);
      if (wr == 1) PG8_BAR;
      PG8_WAIT_V(8); PG8_BAR;
      PG8_WAIT_V(6); PG8_BAR; }
    for (;;) {
        const bool has_next = S.next(ui + 1, nxt);
        const Unit nu = has_next ? nxt : cur;
        const char* nB = (const char*)g.Bt + (size_t)nu.pn * 2 * hstepB;
#pragma unroll 1
        for (int t = 0; t < nt; t += 2) {
            const bool last = (t == nt - 2);
            const char* a1 = AS.tile(cur, t + 1);
            const char* a2 = last ? AS.tile(nu, 0) : AS.tile(cur, t + 2); const char* b2 = last ? nB : cB + (size_t)(t + 2) * kstep;
            const char* a3 = last ? AS.tile(nu, 1) : AS.tile(cur, t + 3); const char* b3 = b2 + kstep;
            PG8_LDB(B0, 0, 0); PG8_LDB(B1, 0, 1); PG8_SCHED; PG8_LDA(At, 0, 0); PG8_STAGE(PG8_SA(1, 1), a1 + hstepA, voffA);
            PG8_WAIT_V(8); PG8_WAIT_L(0); PG8_BAR; PG8_MMA(0, 0, At, B0); PG8_MMA(0, 1, At, B1); PG8_BAR; PG8_SCHED;
            PG8_LDA(At, 0, 1); PG8_STAGE(PG8_SB(0, 0), b2, voffB); PG8_STAGE(PG8_SB(0, 1), b2 + hstepB, voffB); PG8_STAGE(PG8_SA(0, 0), a2, voffA);
            PG8_WAIT_V(8); PG8_WAIT_L(0); PG8_BAR; PG8_MMA(1, 0, At, B0); PG8_MMA(1, 1, At, B1); PG8_BAR; PG8_SCHED;
            PG8_LDB(B0, 1, 0); PG8_LDB(B1, 1, 1); PG8_SCHED; PG8_LDA(At, 1, 0); PG8_STAGE(PG8_SA(0, 1), a2 + hstepA, voffA);
            PG8_WAIT_V(8); PG8_WAIT_L(0); PG8_BAR; PG8_MMA(0, 0, At, B0); PG8_MMA(0, 1, At, B1); PG8_BAR; PG8_SCHED;
            PG8_LDA(At, 1, 1); PG8_STAGE(PG8_SB(1, 0), b3, voffB); PG8_STAGE(PG8_SB(1, 1), b3 + hstepB, voffB); PG8_STAGE(PG8_SA(1, 0), a3, voffA);
            PG8_WAIT_V(8); PG8_WAIT_L(0); PG8_BAR; PG8_MMA(1, 0, At, B0); PG8_MMA(1, 1, At, B1); PG8_BAR; PG8_SCHED;
        }
        if (wr == 0) PG8_BAR;
        if (!has_next && wmat && gtid * 128u < wbytes) asm volatile("global_load_dword %0, %1, off" : "+v"(warmm) : "v"(wmat + (size_t)gtid * 128u) : "memory");
        if (!has_next && warm) warmv = *(const volatile unsigned*)(warm + ((size_t)(tid & 255) * wK + (size_t)(tid >> 8) * BK) * 2);
        if (ui == 0) hook();
        E(acc, cur, wr, wc, fr, fq, lds);
        if (!has_next) break;
#pragma unroll
        for (int a = 0; a < 2; ++a)
#pragma unroll
            for (int b = 0; b < 2; ++b)
#pragma unroll
                for (int m = 0; m < 4; ++m)
#pragma unroll
                    for (int n = 0; n < 2; ++n) acc[a][b][m][n] = (f32x4){0.f, 0.f, 0.f, 0.f};
        cur = nxt; cB = nB; ++ui;
        if (wr == 1) PG8_BAR;
    }
    PG8_WAIT_V(0);
    asm volatile("" :: "v"(warmv), "v"(warmm));
    PG8_BAR;
#undef PG8_SA
#undef PG8_SB
#undef PG8_STAGE
#undef PG8_LDA
#undef PG8_LDB
#undef PG8_MMA
#undef PG8_WAIT_V
#undef PG8_WAIT_L
#undef PG8_BAR
#undef PG8_SCHED
}
}
constexpr int NWAVES = 8;
constexpr int RING_BYTES = 131072;
constexpr int XCH_BYTES = 8192;
constexpr int MISC_OFF = RING_BYTES + XCH_BYTES;
constexpr int LDS_BYTES = 147456;

constexpr size_t W_XQ = 0, W_XO = 2 * MiB, W_1 = 4 * MiB, W_2 = 12 * MiB, W_MIX = 20 * MiB;
constexpr size_t W_GLU = W_MIX, W_BST = W_MIX + 4 * MiB, W_BOUT = W_MIX + 12 * MiB;
constexpr size_t W_QKV = W_MIX + 28 * MiB, W_AO = W_MIX + 46 * MiB;
constexpr size_t BIG_F = 0, BIG_XB = 64 * MiB, BIG_WKV = 96 * MiB;
constexpr int CW_BAR = 4096;

#define GAS __attribute__((address_space(1)))
#define LAS __attribute__((address_space(3)))
typedef GAS unsigned gu32;
#define RLX_AGENT __ATOMIC_RELAXED, __HIP_MEMORY_SCOPE_AGENT
#define LDS_WAIT() asm volatile("s_waitcnt lgkmcnt(0)" ::: "memory")

__device__ __forceinline__ int tid_here(int wave) { int z = 0; asm volatile("" : "+v"(z)); return wave * 64 + (int)__builtin_amdgcn_mbcnt_hi(~0u, __builtin_amdgcn_mbcnt_lo(~0u, (unsigned)z)); }
#define XB_TMO      128
#define XB_XCNT(j)  (256  + 64 * (j))
#define XB_XSUB(j)  (1280 + 64 * (j))
#define XB_XGEN(j)  (2304 + 64 * (j))
#define XB_TOP      3328
#define XB_TOPGEN   3392
#define XB_NLOCAL   3424
#define XB_XCCID    3456
#define XCD_BAR_WORDS 4096
#define XB_SPIN_CAP (1u << 22)
__device__ __forceinline__ unsigned xb_ld(unsigned* p)              { return __hip_atomic_load(p, __ATOMIC_RELAXED, __HIP_MEMORY_SCOPE_AGENT); }
__device__ __forceinline__ unsigned xb_add(unsigned* p, unsigned v) { return __hip_atomic_fetch_add(p, v, __ATOMIC_RELAXED, __HIP_MEMORY_SCOPE_AGENT); }
__device__ __forceinline__ unsigned xb_xcc_id() { return (unsigned)__builtin_amdgcn_s_getreg((3 << 11) | 20) & 0xFu; }
#define XB_SPIN(cond, bar) do { unsigned _sp = 0; while (cond) { __builtin_amdgcn_s_sleep(1); \
    if ((++_sp & 255u) == 0u) { if (xb_ld(&(bar)[XB_TMO])) break; if (_sp > XB_SPIN_CAP) { atomicAdd(&(bar)[XB_TMO], 1u); break; } } } } while (0)
struct XcdBarrier { unsigned* bar; unsigned x; volatile LAS unsigned* st; int wave; };
__device__ __forceinline__ XcdBarrier xcd_barrier_post(unsigned* bar, volatile LAS unsigned* st) {
    XcdBarrier b; b.bar = bar; b.x = xb_xcc_id(); b.st = st; b.wave = __builtin_amdgcn_readfirstlane((int)threadIdx.x >> 6);
    if (threadIdx.x == 0) { (void)xb_add(&bar[XB_XCNT(b.x)], 1u); __hip_atomic_store(&bar[XB_XCCID + blockIdx.x], b.x + 1u, __ATOMIC_RELAXED, __HIP_MEMORY_SCOPE_AGENT); }
    return b;
}
__device__ __forceinline__ void xcd_barrier_complete(unsigned* bar, unsigned x, unsigned& nloc, unsigned& nx) {
    const unsigned G = gridDim.x * gridDim.y * gridDim.z;
    unsigned sum, cnt, mine, sp = 0u;
    for (;;) {
        sum = 0u; cnt = 0u; mine = 0u;
#pragma unroll
        for (unsigned j = 0; j < 16; ++j) { const unsigned c = xb_ld(&bar[XB_XCNT(j)]); sum += c; cnt += (c > 0u) ? 1u : 0u; mine = (j == x) ? c : mine; }
        if (sum == G) break;
        __builtin_amdgcn_s_sleep(1);
        if ((++sp & 255u) == 0u) { if (xb_ld(&bar[XB_TMO])) break; if (sp > XB_SPIN_CAP) { atomicAdd(&bar[XB_TMO], 1u); break; } }
    }
    nloc = mine > 0u ? mine : 1u; nx = cnt > 0u ? cnt : 1u;
}
__device__ __forceinline__ void xcd_barrier(const XcdBarrier& b) {
    asm volatile("s_waitcnt vmcnt(0)" ::: "memory");
    __syncthreads();
    const int tb_ = tid_here(b.wave);
    if (tb_ == 64) asm volatile("buffer_inv sc1\n\ts_waitcnt vmcnt(0)" ::: "memory");
    if (tb_ == 0) {
        unsigned* bar = b.bar;
        __builtin_amdgcn_s_waitcnt(0);
        unsigned nloc = b.st[0], nx = b.st[1];
        if (nloc == 0u) { xcd_barrier_complete(bar, b.x, nloc, nx); b.st[0] = nloc; b.st[1] = nx; }
        const unsigned old = xb_add(&bar[XB_XSUB(b.x)], 1u);
        const unsigned gen = old / nloc;
        if (old == gen * nloc && nloc > 1u) asm volatile("buffer_wbl2 sc1" ::: "memory");
        if (old + 1u == (gen + 1u) * nloc) {
            __builtin_amdgcn_fence(__ATOMIC_RELEASE, "agent");
            asm volatile("s_waitcnt vmcnt(0)" ::: "memory");
            const unsigned og = xb_add(&bar[XB_TOP], 1u);
            const unsigned tg = og / nx;
            if (og + 1u != (tg + 1u) * nx) XB_SPIN(xb_ld(&bar[XB_TOP]) < (tg + 1u) * nx, bar);
            (void)xb_add(&bar[XB_XGEN(b.x)], 1u);
        } else {
            XB_SPIN(xb_ld(&bar[XB_TOP]) < (gen + 1u) * nx, bar);
            asm volatile("s_waitcnt vmcnt(0)" ::: "memory");
        }
    }
    __syncthreads();
}

__device__ __forceinline__ void xcd_arrive(const XcdBarrier& b) {
    asm volatile("s_waitcnt vmcnt(0)" ::: "memory");
    __syncthreads();
    if (tid_here(b.wave) == 0) {
        unsigned* bar = b.bar;
        const unsigned nloc = b.st[0], nx = b.st[1];
        const unsigned old = xb_add(&bar[XB_XSUB(b.x)], 1u);
        const unsigned gen = old / nloc; const bool leader = old + 1u == (gen + 1u) * nloc;
        if (leader) { __builtin_amdgcn_fence(__ATOMIC_RELEASE, "agent"); asm volatile("s_waitcnt vmcnt(0)" ::: "memory"); (void)xb_add(&bar[XB_TOP], 1u); }
        b.st[4] = (gen + 1u) * nx; b.st[5] = leader ? 1u : 0u;
    }
}
__device__ __forceinline__ void xcd_wait(const XcdBarrier& b) {
    if (tid_here(b.wave) == 0) {
        unsigned* bar = b.bar; const unsigned want = b.st[4];
        XB_SPIN(xb_ld(&bar[XB_TOP]) < want, bar);
        if (b.st[5]) (void)xb_add(&bar[XB_XGEN(b.x)], 1u);
    }
    __syncthreads();
}
constexpr int CW_TEAM = 8192;
__device__ __forceinline__ void team_barrier_local(unsigned* ctl, int team, unsigned target, int wave) {
    asm volatile("s_waitcnt vmcnt(0)" ::: "memory");
    __syncthreads();
    const int tb_ = tid_here(wave);
    if (tb_ == 64) asm volatile("buffer_inv sc1\n\ts_waitcnt vmcnt(0)" ::: "memory");
    if (tb_ == 0) {
        unsigned* ctr = ctl + CW_TEAM + team * 16; unsigned* bar = ctl + CW_BAR;
        (void)xb_add(ctr, 1u);
        XB_SPIN(xb_ld(ctr) < target, bar);
    }
    __syncthreads();
}

__device__ __forceinline__ void conv_item(const float* W, int ldw, int K, int c0, int k0, const float* gain, bf16_t* Wt, int n0, LAS float* scr, int lane) {
    f32x4 v[16];
    const int kr = lane >> 4, n4 = (lane & 15) * 4;
    const float* src = W + (size_t)(k0 + kr) * ldw + c0 + n4;
#pragma unroll
    for (int i = 0; i < 16; ++i) v[i] = __builtin_nontemporal_load((const f32x4*)(src + (size_t)(4 * i) * ldw));
    if (gain) {
#pragma unroll
        for (int i = 0; i < 16; ++i) v[i] = v[i] * gain[k0 + 4 * i + kr];
    }
#pragma unroll
    for (int i = 0; i < 16; ++i) { const int k = 4 * i + kr; *(LAS f32x4*)(scr + k * 64 + (n4 ^ (((k >> 3) & 7) << 2))) = v[i]; }
    LDS_WAIT(); asm volatile("" ::: "memory");
    const int c = lane & 7;
#pragma unroll
    for (int j = 0; j < 8; ++j) { const int n = (lane >> 3) + 8 * j; const LAS float* s = scr + (8 * c) * 64 + (n ^ (c << 2));
        u32x4 o; o.x = pg8::cvt_pk_bf16(s[0 * 64], s[1 * 64]); o.y = pg8::cvt_pk_bf16(s[2 * 64], s[3 * 64]); o.z = pg8::cvt_pk_bf16(s[4 * 64], s[5 * 64]); o.w = pg8::cvt_pk_bf16(s[6 * 64], s[7 * 64]);
        *(u32x4*)(Wt + (size_t)(n0 + n) * K + k0 + 8 * c) = o; }
    LDS_WAIT(); asm volatile("" ::: "memory");
}
enum { MAP_ID = 0, MAP_GLU = 1, MAP_QKV = 2 };
__device__ __forceinline__ int map_col(int kind, int arg, int n0) {
    if (kind == MAP_GLU) { const int pn = n0 >> 8, w = n0 & 255; return (w >> 7) * 1024 + pn * 128 + (w & 127); }
    if (kind == MAP_QKV) { return ((n0 >> 10) * 3 + arg) * 1024 + (n0 & 1023); }
    return n0;
}
__device__ __forceinline__ void conv_matrix(const float* W, int ldw, int K, int N, int kind, int arg, const float* gain, bf16_t* Wt, LAS float* scr, int lane, int gw, int NGW, int& rot) {
    const int nblk = N / 64, nitems = (K / 64) * nblk;
    for (int it = (gw + NGW - rot) % NGW; it < nitems; it += NGW) { const int kb = it / nblk, nb = it % nblk; conv_item(W, ldw, K, map_col(kind, arg, nb * 64), kb * 64, gain, Wt, nb * 64, scr, lane); }
    rot = (rot + nitems) % NGW;
}
__device__ __forceinline__ float wsum_l(float v, int lane) {
#pragma unroll
    for (int o = 1; o < 64; o <<= 1) v += pg8::shx(v, lane, o);
    return v;
}
__device__ __forceinline__ float row_f32_to_bf16(const float* xrow, bf16_t* oraw, bf16_t* onorm, int lane) {
    const f32x4* xr = (const f32x4*)xrow + lane;
    f32x4 v[4]; float s = 0.f;
#pragma unroll
    for (int j = 0; j < 4; ++j) { v[j] = xr[64 * j]; s += (v[j].x * v[j].x + v[j].y * v[j].y) + (v[j].z * v[j].z + v[j].w * v[j].w); }
    const float rstd = rsqrtf(wsum_l(s, lane) * (1.0f / DM) + EPS);
    if (oraw) { u32x2* o = (u32x2*)oraw + lane;
#pragma unroll
        for (int j = 0; j < 4; ++j) { u32x2 w; w.x = pk2(v[j].x, v[j].y); w.y = pk2(v[j].z, v[j].w); o[64 * j] = w; } }
    if (onorm) { u32x2* o = (u32x2*)onorm + lane;
#pragma unroll
        for (int j = 0; j < 4; ++j) { u32x2 w; w.x = pk2(v[j].x * rstd, v[j].y * rstd); w.y = pk2(v[j].z * rstd, v[j].w * rstd); o[64 * j] = w; } }
    return rstd;
}
template <bool F32SRC> __device__ __forceinline__ void unorm_chunk(LAS unsigned char* lds, const float* xsrc, bf16_t* hbio, bf16_t* Ug, int chunk, const int tid) {
    const int lane = tid & 63, wid = __builtin_amdgcn_readfirstlane(tid >> 6);
    LAS unsigned char* T = lds;
#pragma unroll
    for (int rr = 0; rr < 2; ++rr) { const int s = 2 * wid + rr; const size_t row = (size_t)chunk * 16 + s;
        if (F32SRC) { const f32x4* xr = (const f32x4*)(xsrc + row * DM) + lane; f32x4 v[4]; float ss = 0.f;
#pragma unroll
            for (int j = 0; j < 4; ++j) { v[j] = __builtin_nontemporal_load(xr + 64 * j); ss += (v[j].x * v[j].x + v[j].y * v[j].y) + (v[j].z * v[j].z + v[j].w * v[j].w); }
            const float rstd = rsqrtf(wsum_l(ss, lane) * (1.0f / DM) + EPS);
            u32x2* o = (u32x2*)(hbio + row * DM) + lane;
#pragma unroll
            for (int j = 0; j < 4; ++j) { u32x2 w; w.x = pg8::cvt_pk_bf16(v[j].x, v[j].y); w.y = pg8::cvt_pk_bf16(v[j].z, v[j].w); o[64 * j] = w;
                u32x2 q; q.x = pg8::cvt_pk_bf16(v[j].x * rstd, v[j].y * rstd); q.y = pg8::cvt_pk_bf16(v[j].z * rstd, v[j].w * rstd); *(LAS u32x2*)(T + s * 2080 + (64 * j + lane) * 8) = q; }
        } else { const u32x4* xr = (const u32x4*)(hbio + row * DM) + lane; u32x4 w[2]; float v[16]; float ss = 0.f;
#pragma unroll
            for (int j = 0; j < 2; ++j) { w[j] = xr[64 * j];
                v[8 * j + 0] = __uint_as_float(w[j].x << 16); v[8 * j + 1] = __uint_as_float(w[j].x & 0xffff0000u); v[8 * j + 2] = __uint_as_float(w[j].y << 16); v[8 * j + 3] = __uint_as_float(w[j].y & 0xffff0000u);
                v[8 * j + 4] = __uint_as_float(w[j].z << 16); v[8 * j + 5] = __uint_as_float(w[j].z & 0xffff0000u); v[8 * j + 6] = __uint_as_float(w[j].w << 16); v[8 * j + 7] = __uint_as_float(w[j].w & 0xffff0000u); }
#pragma unroll
            for (int i = 0; i < 16; ++i) ss += v[i] * v[i];
            const float rstd = rsqrtf(wsum_l(ss, lane) * (1.0f / DM) + EPS);
#pragma unroll
            for (int j = 0; j < 2; ++j) { u32x4 q; q.x = pg8::cvt_pk_bf16(v[8 * j] * rstd, v[8 * j + 1] * rstd); q.y = pg8::cvt_pk_bf16(v[8 * j + 2] * rstd, v[8 * j + 3] * rstd);
                q.z = pg8::cvt_pk_bf16(v[8 * j + 4] * rstd, v[8 * j + 5] * rstd); q.w = pg8::cvt_pk_bf16(v[8 * j + 6] * rstd, v[8 * j + 7] * rstd); *(LAS u32x4*)(T + s * 2080 + (64 * j + lane) * 16) = q; } }
    }
    LDS_WAIT(); __syncthreads();
#pragma unroll
    for (int i = 0; i < 4; ++i) { const int gq = 8 * wid + 2 * i + (lane >> 5), l = lane & 31, s = l >> 1, hf = l & 1;
        const u32x4 q = *(const LAS u32x4*)(T + s * 2080 + gq * 32 + hf * 16);
        *(u32x4*)(Ug + ((size_t)gq * 1024 + chunk) * 256 + l * 8) = q; }
    LDS_WAIT(); __syncthreads();
}

struct S5In { const float *lam_re, *lam_im, *log_dt, *b_re, *b_im, *c_re, *c_im, *dskip, *gain; };
typedef float f32x2v __attribute__((ext_vector_type(2)));
__device__ __forceinline__ void s5_gen(LAS unsigned char* lds, const S5In P, int g, int q, bf16_t* Bst, bf16_t* Bout, const int tid) {
    LAS f32x2v* pw = (LAS f32x2v*)lds;
    LAS f32x2v* bb = (LAS f32x2v*)(lds + 17408);
    LAS f32x2v* cc = (LAS f32x2v*)(lds + 33792);
    LAS float* kt = (LAS float*)(lds + 50176);
    if (tid < 128) {
        const int di = tid >> 6, p = tid & 63, gp = (di * 64 + g) * 64 + p;
        const float dt = __builtin_amdgcn_exp2f(P.log_dt[di * 64 + g] * 1.4426950408889634f);
        const float lr = P.lam_re[gp], li = P.lam_im[gp];
        const float mag = __builtin_amdgcn_exp2f(lr * dt * 1.4426950408889634f), frv = __builtin_amdgcn_fractf(li * dt * 0.15915494309189535f);
        const float ar = mag * __builtin_amdgcn_cosf(frv), ai = mag * __builtin_amdgcn_sinf(frv);
        const float nr = ar - 1.0f, ni = ai, den = lr * lr + li * li;
        const float fr = (nr * lr + ni * li) / den, fi = (ni * lr - nr * li) / den;
        float wr = 1.0f, wi = 0.0f;
        for (int k = 0; k <= 16; ++k) { pw[(di * 64 + p) * 17 + k] = (f32x2v){wr, wi}; const float t = wr * ar - wi * ai; wi = wr * ai + wi * ar; wr = t; }
        for (int c = 0; c < 16; ++c) { const float br = P.b_re[(size_t)gp * 16 + c], bi = P.b_im[(size_t)gp * 16 + c];
            bb[(di * 64 + p) * 16 + c] = (f32x2v){fr * br - fi * bi, fr * bi + fi * br}; }
    }
    for (int e = tid; e < 2048; e += 512) { const int di = e >> 10, c = (e >> 6) & 15, p = e & 63; const size_t o = ((size_t)(di * 64 + g) * 16 + c) * 64 + p; cc[e] = (f32x2v){P.c_re[o], P.c_im[o]}; }
    __syncthreads();
    { const int di = tid >> 8, k = (tid >> 4) & 15, chb = (tid >> 2) & 3, c2b = tid & 3;
      float acc[4][4];
#pragma unroll
      for (int a_ = 0; a_ < 4; ++a_)
#pragma unroll
          for (int b_ = 0; b_ < 4; ++b_) acc[a_][b_] = 0.f;
      for (int p = 0; p < 64; ++p) { const f32x2v w = pw[(di * 64 + p) * 17 + k]; float zr[4], zi[4];
#pragma unroll
          for (int b_ = 0; b_ < 4; ++b_) { const f32x2v b = bb[(di * 64 + p) * 16 + 4 * c2b + b_]; zr[b_] = w.x * b.x - w.y * b.y; zi[b_] = w.x * b.y + w.y * b.x; }
#pragma unroll
          for (int a_ = 0; a_ < 4; ++a_) { const f32x2v C = cc[(di * 16 + 4 * chb + a_) * 64 + p];
#pragma unroll
              for (int b_ = 0; b_ < 4; ++b_) acc[a_][b_] += C.x * zr[b_] - C.y * zi[b_]; } }
#pragma unroll
      for (int a_ = 0; a_ < 4; ++a_)
#pragma unroll
          for (int b_ = 0; b_ < 4; ++b_) kt[((di * 16 + k) * 16 + 4 * chb + a_) * 16 + 4 * c2b + b_] = acc[a_][b_]; }
    __syncthreads();
    { const int di = q >> 1, ri = q & 1;
      for (int cid = tid; cid < 2048; cid += 512) { const int nl = cid >> 5, k0 = (cid & 31) * 8, r = k0 >> 4, ch0 = k0 & 15;
        const f32x2v w = pw[(di * 64 + nl) * 17 + (di == 0 ? 15 - r : r)]; float v[8];
#pragma unroll
        for (int j = 0; j < 8; ++j) { const f32x2v b = bb[(di * 64 + nl) * 16 + ch0 + j]; const float zr = w.x * b.x - w.y * b.y, zi = w.x * b.y + w.y * b.x; v[j] = (ri == 0 ? zr : zi) * P.gain[g * 16 + ch0 + j]; }
        u32x4 o; o.x = pk2(v[0], v[1]); o.y = pk2(v[2], v[3]); o.z = pk2(v[4], v[5]); o.w = pk2(v[6], v[7]);
        *(u32x4*)(Bst + ((size_t)g * 256 + q * 64 + nl) * 256 + k0) = o; } }
    for (int cid = tid; cid < 4096; cid += 512) { const int nl = cid >> 6, k0 = (cid & 63) * 8, n = q * 64 + nl, s = n >> 4, ch = n & 15; float v[8];
        if (k0 < 256) { const int r = k0 >> 4, c0 = k0 & 15;
#pragma unroll
            for (int j = 0; j < 8; ++j) { const int c2 = c0 + j; float t = 0.f;
                if (r <= s) t += kt[((0 * 16 + (s - r)) * 16 + ch) * 16 + c2];
                if (r >= s) t += kt[((1 * 16 + (r - s)) * 16 + ch) * 16 + c2];
                if (r == s && c2 == ch) t += P.dskip[g * 16 + ch];
                v[j] = t * P.gain[g * 16 + c2]; }
        } else { const int kk = k0 - 256, di = kk >> 7, ri = (kk >> 6) & 1, p0 = kk & 63;
#pragma unroll
            for (int j = 0; j < 8; ++j) { const int p = p0 + j; const f32x2v C = cc[(di * 16 + ch) * 64 + p], w = pw[(di * 64 + p) * 17 + (di == 0 ? s + 1 : 16 - s)];
                v[j] = ri == 0 ? (C.x * w.x - C.y * w.y) : -(C.x * w.y + C.y * w.x); } }
        u32x4 o; o.x = pk2(v[0], v[1]); o.y = pk2(v[2], v[3]); o.z = pk2(v[4], v[5]); o.w = pk2(v[6], v[7]);
        *(u32x4*)(Bout + ((size_t)g * 256 + n) * 512 + k0) = o; }
    __syncthreads();
}

__device__ __forceinline__ void s5_scan_bg(LAS unsigned char* lds, const S5In P, const bf16_t* F, bf16_t* XB, int b, int g, const int tid) {
    const int lane = tid & 63, wid = __builtin_amdgcn_readfirstlane(tid >> 6), p = lane;
    LAS f32x2v* E = (LAS f32x2v*)lds;
    LAS f32x2v* XI = (LAS f32x2v*)(lds + 16384);
    float a1r[2], a1i[2], a16r[2], a16i[2];
#pragma unroll
    for (int di = 0; di < 2; ++di) { const int gp = (di * 64 + g) * 64 + p;
        const float dt = expf(P.log_dt[di * 64 + g]); const float lr = P.lam_re[gp], li = P.lam_im[gp];
        const float mag = expf(lr * dt), ang = li * dt; float ar = mag * cosf(ang), ai = mag * sinf(ang);
#pragma unroll
        for (int sq = 0; sq < 4; ++sq) { const float t = ar * ar - ai * ai; ai = 2.f * ar * ai; ar = t; }
        a1r[di] = ar; a1i[di] = ai;
#pragma unroll
        for (int sq = 0; sq < 4; ++sq) { const float t = ar * ar - ai * ai; ai = 2.f * ar * ai; ar = t; }
        a16r[di] = ar; a16i[di] = ai; }
    const bf16_t* Fb = F + ((size_t)g * 1024 + b * 256) * 256;
    float fr[4][16], fi[4][16];
#pragma unroll
    for (int jj = 0; jj < 4; ++jj) { const int job = wid + 8 * jj, di = job >> 4, seg = job & 15;
#pragma unroll
        for (int j = 0; j < 16; ++j) { const int c = di == 0 ? seg * 16 + j : 255 - (seg * 16 + j); const bf16_t* fp = Fb + (size_t)c * 256 + di * 128 + p; fr[jj][j] = bf2f(fp[0]); fi[jj][j] = bf2f(fp[64]); } }
#pragma unroll
    for (int jj = 0; jj < 4; ++jj) { const int job = wid + 8 * jj, di = job >> 4, seg = job & 15;
        const float ar = di ? a1r[1] : a1r[0], ai = di ? a1i[1] : a1i[0]; float xr = 0.f, xi = 0.f;
#pragma unroll
        for (int j = 0; j < 16; ++j) { const float nxr = ar * xr - ai * xi + fr[jj][j], nxi = ar * xi + ai * xr + fi[jj][j]; xr = nxr; xi = nxi; }
        E[(di * 16 + seg) * 64 + p] = (f32x2v){xr, xi}; }
    LDS_WAIT(); __syncthreads();
    if (tid < 128) { const int di = tid >> 6; const float ar = di ? a16r[1] : a16r[0], ai = di ? a16i[1] : a16i[0]; float xr = 0.f, xi = 0.f;
        for (int seg = 0; seg < 16; ++seg) { XI[(di * 16 + seg) * 64 + p] = (f32x2v){xr, xi}; const f32x2v e = E[(di * 16 + seg) * 64 + p];
            const float nxr = ar * xr - ai * xi + e.x, nxi = ar * xi + ai * xr + e.y; xr = nxr; xi = nxi; } }
    LDS_WAIT(); __syncthreads();
#pragma unroll
    for (int jj = 0; jj < 4; ++jj) { const int job = wid + 8 * jj, di = job >> 4, seg = job & 15;
        const float ar = di ? a1r[1] : a1r[0], ai = di ? a1i[1] : a1i[0]; const f32x2v x0 = XI[(di * 16 + seg) * 64 + p]; float xr = x0.x, xi = x0.y;
        bf16_t* xg = XB + ((size_t)g * 1024 + b * 256) * 256 + di * 128 + p;
#pragma unroll
        for (int j = 0; j < 16; ++j) { const int c = di == 0 ? seg * 16 + j : 255 - (seg * 16 + j);
            xg[(size_t)c * 256] = (bf16_t)f2bf(xr); xg[(size_t)c * 256 + 64] = (bf16_t)f2bf(xi);
            const float nxr = ar * xr - ai * xi + fr[jj][j], nxi = ar * xi + ai * xr + fi[jj][j]; xr = nxr; xi = nxi; } }
    __syncthreads();
}
namespace att {
typedef float f32x16 __attribute__((ext_vector_type(16)));
typedef short bf16x8 __attribute__((ext_vector_type(8)));
typedef short v4i16_t __attribute__((ext_vector_type(4)));
typedef LAS const char* lds_cptr;
__device__ __forceinline__ v4i16_t vtr(lds_cptr p) { return __builtin_amdgcn_ds_read_tr16_b64_v4i16((LAS v4i16_t*)p); }
__device__ __forceinline__ void glds16(const void* gsrc, LAS unsigned char* dst_uniform) { __builtin_amdgcn_global_load_lds((const unsigned*)gsrc, (LAS unsigned*)dst_uniform, 16, 0, 0); }
__device__ __forceinline__ unsigned pkbf(float lo, float hi) { return pg8::cvt_pk_bf16(lo, hi); }
__device__ __forceinline__ bf16x8 pack8(const f32x16& p, int base) {
    u32x4 w; w.x = pkbf(p[base + 0], p[base + 1]); w.y = pkbf(p[base + 2], p[base + 3]); w.z = pkbf(p[base + 4], p[base + 5]); w.w = pkbf(p[base + 6], p[base + 7]);
    return __builtin_bit_cast(bf16x8, w);
}
#define ATT_SYNC() do { asm volatile("s_waitcnt vmcnt(0) lgkmcnt(0)" ::: "memory"); __syncthreads(); } while (0)

template <bool MERGE> __device__ __forceinline__ void store_ot(const f32x16& acc, float sc, bf16_t* rowp  , int hi, float wa, float wb, const u32x4 (&oldv)[2]) {
    unsigned w[8];
#pragma unroll
    for (int g = 0; g < 4; ++g) { w[2 * g] = pkbf(acc[4 * g] * sc, acc[4 * g + 1] * sc); w[2 * g + 1] = pkbf(acc[4 * g + 2] * sc, acc[4 * g + 3] * sc); }
#pragma unroll
    for (int g = 0; g < 4; g += 2) {
        const auto rx = __builtin_amdgcn_permlane32_swap(w[2 * g], w[2 * g + 2], false, false);
        const auto ry = __builtin_amdgcn_permlane32_swap(w[2 * g + 1], w[2 * g + 3], false, false);
        u32x4 o; o.x = rx[0]; o.y = ry[0]; o.z = rx[1]; o.w = ry[1];
        u32x4* dst = (u32x4*)(rowp + 8 * g + (hi ? 8 : 0));
        if (MERGE) { const u32x4 old = oldv[g >> 1];
#define ATT_MRG(N, O) pkbf(__uint_as_float((O) << 16) * wa + __uint_as_float((N) << 16) * wb, __uint_as_float((O) & 0xffff0000u) * wa + __uint_as_float((N) & 0xffff0000u) * wb)
            o.x = ATT_MRG(o.x, old.x); o.y = ATT_MRG(o.y, old.y); o.z = ATT_MRG(o.z, old.z); o.w = ATT_MRG(o.w, old.w);
#undef ATT_MRG
        }
        *dst = o;
    }
}

__device__ __forceinline__ void xattn_unit(LAS unsigned char* lds, const bf16_t* Qx, const bf16_t* KV, int li, int b, int h, int qb, bf16_t* XO, const int tid) {
    const int lane = tid & 63, wid = __builtin_amdgcn_readfirstlane(tid >> 6), r32 = lane & 31, hi = lane >> 5;
    const size_t tok = (size_t)b * SEQ + qb * 256 + wid * 32 + r32;
    const bf16_t* Kb = KV + (size_t)b * MEMLEN * 8192 + li * 2048 + h * 256;
#pragma unroll 4
    for (int ii = 0; ii < 16; ++ii) { const int i = wid * 16 + ii, key = 2 * i + hi, c = r32 ^ (key & 15);
        glds16(Kb + (size_t)key * 8192 + c * 8, lds + i * 1024); }
    bf16x8 qf[16]; { const bf16_t* qp = Qx + tok * 1024 + h * 256 + hi * 8;
#pragma unroll
        for (int s = 0; s < 16; ++s) qf[s] = *(const bf16x8*)(qp + 16 * s); }
    ATT_SYNC();
    f32x16 S[8];
#pragma unroll
    for (int kt = 0; kt < 8; ++kt) { f32x16 acc = {}; const lds_cptr kp = (lds_cptr)lds + (32 * kt + r32) * 512;
#pragma unroll
        for (int s = 0; s < 16; ++s) { const bf16x8 kf = *(const LAS bf16x8*)(kp + (((2 * s + hi) ^ (r32 & 15)) << 4)); acc = __builtin_amdgcn_mfma_f32_32x32x16_bf16(kf, qf[s], acc, 0, 0, 0); }
        S[kt] = acc; }
    float m = S[0][0];
#pragma unroll
    for (int kt = 0; kt < 8; ++kt)
#pragma unroll
        for (int r = 0; r < 16; ++r) m = fmaxf(m, S[kt][r]);
    m = fmaxf(m, pg8::shx(m, lane, 32));
    float l = 0.f;
#pragma unroll
    for (int kt = 0; kt < 8; ++kt)
#pragma unroll
        for (int r = 0; r < 16; ++r) { const float p = __builtin_amdgcn_exp2f(S[kt][r] - m); S[kt][r] = p; l += p; }
    l += pg8::shx(l, lane, 32);
    const float inv = __builtin_amdgcn_rcpf(l);
    bf16x8 pf[16];
#pragma unroll
    for (int kt = 0; kt < 8; ++kt) { pf[2 * kt] = pack8(S[kt], 0); pf[2 * kt + 1] = pack8(S[kt], 8); }
    ATT_SYNC();
    const bf16_t* Vb = Kb + 1024;
#pragma unroll 4
    for (int ii = 0; ii < 16; ++ii) { const int i = wid * 16 + ii, d0 = i >> 4, ks = i & 15, key = 16 * ks + 8 * hi + ((lane >> 2) & 7), cc = lane & 3;
        glds16(Vb + (size_t)key * 8192 + 32 * d0 + 8 * cc, lds + i * 1024); }
    ATT_SYNC();
    const lds_cptr vb = (lds_cptr)lds + ((lane >> 4) & 1) * 32 + (lane & 3) * 8 + (4 * hi + ((lane & 15) >> 2)) * 64;
    bf16_t* orow = XO + tok * 1024 + h * 256;
#pragma unroll 1
    for (int d0 = 0; d0 < 8; ++d0) { f32x16 acc = {};
#pragma unroll
        for (int ks = 0; ks < 16; ++ks) { const v4i16_t lo = vtr(vb + d0 * 16384 + ks * 1024), hh = vtr(vb + d0 * 16384 + ks * 1024 + 512);
            const bf16x8 vf = {lo[0], lo[1], lo[2], lo[3], hh[0], hh[1], hh[2], hh[3]};
            acc = __builtin_amdgcn_mfma_f32_32x32x16_bf16(vf, pf[ks], acc, 0, 0, 0); }
        const u32x4 none[2] = {}; store_ot<false>(acc, inv, orow + 32 * d0, hi, 0.f, 0.f, none); }
    ATT_SYNC();
}

__device__ __forceinline__ void dil_unit(LAS unsigned char* lds, const LAS float* btab, const bf16_t* QKV, int gi, int ldil, int b, int h, int r, int ub, bf16_t* AO, float* lseacc, const int tid) {
    const int lane = tid & 63, wid = __builtin_amdgcn_readfirstlane(tid >> 6), r32 = lane & 31, hi = lane >> 5;
    const int sub_len = SEQ >> ldil, k0 = ub * 256 - 64;
    const size_t tokb = (size_t)b * SEQ + r;
    const bf16_t* base = QKV + h * 128;
#pragma unroll 4
    for (int ii = 0; ii < 12; ++ii) { const int i = wid * 12 + ii, kk = 4 * i + (lane >> 4), c = (lane & 15) ^ (kk & 15); int ki = k0 + kk; ki = ki < 0 ? 0 : (ki >= sub_len ? sub_len - 1 : ki);
        glds16(base + (tokb + ((size_t)ki << ldil)) * 3072 + 1024 + c * 8, lds + i * 1024); }
    const int qi = ub * 256 + wid * 32 + r32; const size_t qtok = tokb + ((size_t)qi << ldil);
    bf16x8 qf[8]; { const bf16_t* qp = base + qtok * 3072 + hi * 8;
#pragma unroll
        for (int s = 0; s < 8; ++s) qf[s] = *(const bf16x8*)(qp + 16 * s); }
    ATT_SYNC();
    f32x16 S[5];
    int r15 = r32 & 15; asm volatile("" : "+v"(r15));
#pragma unroll
    for (int t = 0; t < 5; ++t) { f32x16 acc = {}; const lds_cptr kp = (lds_cptr)lds + (32 * wid + 32 * t + r32) * 256;
#pragma unroll
        for (int s = 0; s < 8; ++s) { const bf16x8 kf = *(const LAS bf16x8*)(kp + (((2 * s + hi) ^ r15) << 4)); acc = __builtin_amdgcn_mfma_f32_32x32x16_bf16(kf, qf[s], acc, 0, 0, 0); }
        S[t] = acc; }
    ATT_SYNC();
#pragma unroll 1
    for (int ii = 0; ii < 12; ++ii) { const int i = wid * 12 + ii, d0 = i / 24, ks = i % 24, kk = 16 * ks + 8 * hi + ((lane >> 2) & 7), cc = lane & 3; int ki = k0 + kk; ki = ki < 0 ? 0 : (ki >= sub_len ? sub_len - 1 : ki);
        glds16(base + (tokb + ((size_t)ki << ldil)) * 3072 + 2048 + 32 * d0 + 8 * cc, lds + i * 1024); }
    float m = -3.0e38f;
#pragma unroll
    for (int t = 0; t < 5; ++t)
#pragma unroll
        for (int rr = 0; rr < 16; ++rr) { const int cr = (rr & 3) + 8 * (rr >> 2) + 4 * hi, jk = 32 * t + cr - r32, ki = k0 + 32 * wid + 32 * t + cr;
            float s = S[t][rr] + btab[jk + 32];
            s = ((unsigned)ki < (unsigned)sub_len) ? s : -1e30f;
            S[t][rr] = s; m = fmaxf(m, s); }
    m = fmaxf(m, pg8::shx(m, lane, 32));
    float l = 0.f;
#pragma unroll
    for (int t = 0; t < 5; ++t)
#pragma unroll
        for (int rr = 0; rr < 16; ++rr) { const float p = __builtin_amdgcn_exp2f(S[t][rr] - m); S[t][rr] = p; l += p; }
    l += pg8::shx(l, lane, 32);
    const float inv = __builtin_amdgcn_rcpf(l), lse = m + __builtin_amdgcn_logf(l);
    bf16x8 pf[10];
#pragma unroll
    for (int t = 0; t < 5; ++t) { pf[2 * t] = pack8(S[t], 0); pf[2 * t + 1] = pack8(S[t], 8); }
    bf16_t* orow = AO + qtok * 1024 + h * 128;
    u32x4 oldv[4][2] = {};
    if (gi > 0) {
#pragma unroll
        for (int d0 = 0; d0 < 4; ++d0)
#pragma unroll
            for (int g2 = 0; g2 < 2; ++g2) oldv[d0][g2] = *(const u32x4*)(orow + 32 * d0 + 16 * g2 + (hi ? 8 : 0)); }
    float wa = 0.f, wb = 1.f, ln = lse;
    float* lp = lseacc + qtok * 8 + h;
    if (gi > 0) { const float la = *lp, mx = fmaxf(la, lse); ln = mx + __builtin_amdgcn_logf(__builtin_amdgcn_exp2f(la - mx) + __builtin_amdgcn_exp2f(lse - mx)); wa = __builtin_amdgcn_exp2f(la - ln); wb = __builtin_amdgcn_exp2f(lse - ln); }
    ATT_SYNC();
    const lds_cptr vb = (lds_cptr)lds + ((lane >> 4) & 1) * 32 + (lane & 3) * 8 + (4 * hi + ((lane & 15) >> 2)) * 64 + 2 * wid * 1024;
#pragma unroll
    for (int d0 = 0; d0 < 4; ++d0) { f32x16 acc = {};
#pragma unroll
        for (int k = 0; k < 10; ++k) { const v4i16_t lo = vtr(vb + (d0 * 24 + k) * 1024), hh = vtr(vb + (d0 * 24 + k) * 1024 + 512);
            const bf16x8 vf = {lo[0], lo[1], lo[2], lo[3], hh[0], hh[1], hh[2], hh[3]};
            acc = __builtin_amdgcn_mfma_f32_32x32x16_bf16(vf, pf[k], acc, 0, 0, 0); }
        if (gi > 0) store_ot<true>(acc, inv, orow + 32 * d0, hi, wa, wb, oldv[d0]); else store_ot<false>(acc, inv, orow + 32 * d0, hi, 0.f, 0.f, oldv[d0]); }
    if (hi == 0) *lp = ln;
    ATT_SYNC();
}
#undef ATT_SYNC
}
struct Args { const float* in[27]; float* out; unsigned char* ws; int ph_lo, ph_hi; };
static_assert(sizeof(Args) == 27 * 8 + 8 + 8 + 8, "Args must have no padding");
enum { K_NONE = 0, K_PREP, K_S5STATE, K_SCAN, K_S5OUT, K_GLU, K_KV, K_QKV, K_DIL, K_RES, K_XQ, K_XATTN, K_MLP1 };
__host__ __device__ __forceinline__ int phase_kind(int li, int sub) {
    const bool odd = li & 1;
    switch (sub) {
        case 0: return K_PREP;
        case 1: return odd ? K_QKV : K_S5STATE;
        case 2: return odd ? K_DIL : K_NONE;
        case 3: return odd ? K_QKV : K_NONE;
        case 4: return odd ? K_DIL : K_GLU;
        case 5: return odd ? K_QKV : K_NONE;
        case 6: return odd ? K_DIL : K_NONE;
        case 7: return odd ? K_RES : K_NONE;
        case 8: return K_XQ;
        case 9: return K_NONE;
        case 10: return K_RES;
        case 11: return K_MLP1;
        case 12: return K_RES;
        default: return K_NONE;
    }
}

__global__ void __launch_bounds__(NWAVES * 64, 2) mk_fwd(Args a) {
    extern __shared__ __attribute__((aligned(16))) unsigned char lds_raw[];
    LAS unsigned char* lds = (LAS unsigned char*)lds_raw;
    const int tid0 = threadIdx.x, wave0 = __builtin_amdgcn_readfirstlane(tid0 >> 6);
    const int G = gridDim.x, bx = blockIdx.x, vcu = (G % 8 == 0) ? (bx % 8) * (G / 8) + bx / 8 : bx, NGW = G * NWAVES;
    volatile LAS unsigned* MISC = (volatile LAS unsigned*)(lds + MISC_OFF);
    for (int u = tid0; u < 64; u += NWAVES * 64) MISC[u] = 0u;
    __syncthreads();
    volatile LAS unsigned long long* LP = (volatile LAS unsigned long long*)(lds + MISC_OFF + 256);
    if (tid0 == 0) {
#pragma unroll
        for (int i = 0; i < 27; ++i) LP[i] = (unsigned long long)a.in[i];
        LP[27] = (unsigned long long)a.out; LP[28] = (unsigned long long)a.ws;
    }
    __syncthreads();
#define LDP(i) ((unsigned char*)(GAS unsigned char*)(((unsigned long long)(unsigned)__builtin_amdgcn_readfirstlane((int)(LPv[i] >> 32)) << 32) | (unsigned long long)(unsigned)__builtin_amdgcn_readfirstlane((int)(unsigned)LPv[i])))
#define INP(i) ((const float*)LDP(i))
    XcdBarrier bar = xcd_barrier_post((unsigned*)(a.ws + WS_CTL) + CW_BAR, MISC + 8);
#define out ((float*)LDP(27))
#define ssq ((float*)(wsb + WS_SSQ))
#define rstd_mem ((float*)(wsb + WS_MISC))
#define biasrel ((float*)(wsb + WS_MISC + 16384))
#define hb ((bf16_t*)(wsb + WS_HB))
#define kvall ((bf16_t*)(wsb + WS_KV))
#define memb ((bf16_t*)(wsb + WS_MEMB))
#define T1 ((bf16_t*)(wsb + WS_T1))
#define T2 ((bf16_t*)(wsb + WS_T2))
#define BIG (wsb + WS_BIG)
#define WR (wsb + WS_W)

#ifndef STAG_TICKS
#define STAG_TICKS 0
#endif
#define STAGGER() do { if (STAG_TICKS) { const unsigned long long t0_ = __builtin_amdgcn_s_memrealtime(); const unsigned long long dl_ = (unsigned long long)(vcu >> 6) * STAG_TICKS; while (__builtin_amdgcn_s_memrealtime() - t0_ < dl_) __builtin_amdgcn_s_sleep(1); } } while (0)
    bool first = true;
#ifndef SPLIT_WAR_SEAMS
#define SPLIT_WAR_SEAMS 1
#endif
#ifndef TEAM_LOCAL_SEAMS
#define TEAM_LOCAL_SEAMS 1
#endif
#ifdef DUP_KIND
    bool dupdone = false;
#else
    const bool dupdone = false;
#endif
    for (int ph = a.ph_lo; ph < a.ph_hi; ++ph) {
        const int li = ph >> 4, sub = ph & 15, j = li >> 1, kind = phase_kind(li, sub);
        if (kind == K_NONE) continue;
        unsigned lpo = MISC_OFF + 256; asm volatile("" : "+v"(lpo));
        volatile LAS unsigned long long* LPv = (volatile LAS unsigned long long*)(lds + lpo);
#ifndef REP_GRID
#define REP_GRID 1
#endif
        const bool teamseam = TEAM_LOCAL_SEAMS && G == 256 && !dupdone && (sub == 8 || sub == 10 || sub == 11 || sub == 12) && MISC[8 + 2] != 0u;
        const bool warseam = SPLIT_WAR_SEAMS && G == 256 && !dupdone && kind == K_QKV && sub != 1;
#ifndef SPLIT_PREP_SEAMS
#define SPLIT_PREP_SEAMS 1
#endif
        const bool prepseam = SPLIT_PREP_SEAMS && G == 256 && !dupdone && kind == K_PREP && li > 0;
        if (!first && (warseam || prepseam)) { XcdBarrier b2 = bar; b2.bar = (unsigned*)(LDP(28) + WS_CTL) + CW_BAR; xcd_arrive(b2); }
        else if (!first && teamseam) { const unsigned tbk = 4u * (unsigned)li + (sub == 8 ? 1u : (sub == 10 ? 2u : (sub == 11 ? 3u : 4u)));
            team_barrier_local((unsigned*)(LDP(28) + WS_CTL), 8 * (bx & 7) + ((bx >> 3) & 7), 4u * tbk, wave0); }
        else if (!first) { for (int rp = 0; rp < REP_GRID; ++rp) { XcdBarrier b2 = bar; b2.bar = (unsigned*)(LDP(28) + WS_CTL) + CW_BAR; xcd_barrier(b2); }
            if (G == 256 && li == 0 && sub == 1 && tid_here(wave0) == 0) { unsigned* bw = (unsigned*)(LDP(28) + WS_CTL) + CW_BAR; const unsigned me = xb_ld(&bw[XB_XCCID + bx]); bool loc = true;
                for (int q = 0; q < 4; ++q) loc = loc && (xb_ld(&bw[XB_XCCID + (bx & 63) + 64 * q]) == me);
                if (loc) (void)xb_add(&bw[XB_NLOCAL], 1u); }
            if (G == 256 && li == 0 && sub == 4) { if (tid_here(wave0) == 0) { unsigned* bw = (unsigned*)(LDP(28) + WS_CTL) + CW_BAR; MISC[8 + 2] = (xb_ld(&bw[XB_NLOCAL]) == (unsigned)G) ? 1u : 0u; } __syncthreads(); }
        }
        first = false;
        unsigned char* const wsb = LDP(28);
#define PHASE_TID int zero_ = 0; asm volatile("" : "+v"(zero_)); const int tid = wave0 * 64 + (int)__builtin_amdgcn_mbcnt_hi(~0u, __builtin_amdgcn_mbcnt_lo(~0u, (unsigned)zero_)); \
        const int lane = tid & 63, wave = wave0, gw = vcu * NWAVES + wave0; (void)lane; (void)wave; (void)gw
#define SP_INIT const S5In sp{INP(7) + (size_t)j * 8192, INP(8) + (size_t)j * 8192, INP(9) + (size_t)j * 128, INP(10) + (size_t)j * 131072, INP(11) + (size_t)j * 131072, \
                      INP(12) + (size_t)j * 131072, INP(13) + (size_t)j * 131072, INP(14) + (size_t)j * DM, INP(3) + (size_t)li * DM}
        if (kind == K_PREP) { PHASE_TID;
            LAS float* scr = (LAS float*)(lds + wave * 16384);
            int rot = 0;
            if (!(li & 1)) { SP_INIT; for (int it = bx; it < 256; it += G) s5_gen(lds, sp, it >> 2, it & 3, (bf16_t*)(WR + W_BST), (bf16_t*)(WR + W_BOUT), tid);
                conv_matrix(INP(15) + (size_t)j * DM * 2048, 2048, DM, 2048, MAP_GLU, 0, nullptr, (bf16_t*)(WR + W_GLU), scr, lane, gw, NGW, rot);
            } else {
                conv_matrix(INP(17) + (size_t)j * DM * DM, DM, DM, DM, MAP_ID, 0, nullptr, (bf16_t*)(WR + W_AO), scr, lane, gw, NGW, rot);
                for (int gi = 2; gi >= 0; --gi)
                    conv_matrix(INP(16) + (size_t)j * DM * 9216, 9216, DM, 3072, MAP_QKV, gi, INP(3) + (size_t)li * DM, (bf16_t*)(WR + W_QKV) + (size_t)gi * 3072 * DM, scr, lane, gw, NGW, rot);
            }
            if (prepseam) { XcdBarrier b2 = bar; b2.bar = (unsigned*)(LDP(28) + WS_CTL) + CW_BAR; xcd_wait(b2);
                if (tid == 64) asm volatile("buffer_inv sc1\n\ts_waitcnt vmcnt(0)" ::: "memory");
                __syncthreads(); }
            conv_matrix(INP(20) + (size_t)li * DM * DM, DM, DM, DM, MAP_ID, 0, INP(4) + (size_t)li * DM, (bf16_t*)(WR + W_XQ), scr, lane, gw, NGW, rot);
            conv_matrix(INP(22) + (size_t)li * DM * DM, DM, DM, DM, MAP_ID, 0, nullptr, (bf16_t*)(WR + W_XO), scr, lane, gw, NGW, rot);
            conv_matrix(INP(25) + (size_t)li * DM * DFF, DFF, DM, DFF, MAP_ID, 0, INP(6) + (size_t)li * DM, (bf16_t*)(WR + W_1), scr, lane, gw, NGW, rot);
            conv_matrix(INP(26) + (size_t)li * DFF * DM, DM, DFF, DM, MAP_ID, 0, nullptr, (bf16_t*)(WR + W_2), scr, lane, gw, NGW, rot);
            if (!(li & 1)) {
                __syncthreads();
                if (li == 0) { for (int ck = vcu; ck < M / 16; ck += G) unorm_chunk<true>(lds, INP(0), hb, T2, ck, tid); }
                else { for (int ck = vcu; ck < M / 16; ck += G) unorm_chunk<false>(lds, nullptr, hb, T2, ck, tid); }
            }
            if (li == 0) {
                for (int l = 0; l < DEPTH; ++l)
                    conv_matrix(INP(21) + (size_t)l * DM * 2048, 2048, DM, 2048, MAP_ID, 0, INP(5) + (size_t)l * DM, (bf16_t*)(BIG + BIG_WKV) + (size_t)l * 2048 * DM, scr, lane, gw, NGW, rot);
                for (int m = gw; m < MROWS; m += NGW) { const float r = row_f32_to_bf16(INP(1) + (size_t)m * DM, memb + (size_t)m * DM, nullptr, lane); if (lane == 0) rstd_mem[m] = r; }
                if (bx == 0) for (int idx = tid; idx < 24 * 129; idx += NWAVES * 64) {
                    const int gh = idx / 129, jk = idx % 129, gi = gh / 8, dil = gi == 0 ? 1 : (gi == 1 ? 4 : 16), rel = (jk - 64) * dil, n = rel < 0 ? -rel : rel;
                    int bucket = rel > 0 ? 16 : 0;
                    if (n < 8) bucket += n; else { int large = 8 + (int)(logf((float)n / 8.0f) / logf(128.0f) * 8.0f); if (large > 15) large = 15; bucket += large; }
                    biasrel[idx] = INP(2)[bucket * 24 + gh] * LOG2E; }
            }
            __syncthreads();
        }
        if ((kind == K_XQ || (kind == K_S5STATE && li == 0))) { PHASE_TID;
            const bool kv = kind != K_XQ;
            const pg8::Gemm g{kv ? (const bf16_t*)(BIG + BIG_WKV) : (const bf16_t*)(WR + W_XQ), kv ? MROWS : M, kv ? 8192 : DM, DM};
            const pg8::ASrcLinear AS{kv ? (const char*)memb : (const char*)hb, DM};
            pg8::StaticOrder S; S.init(g.M, g.N, G, bx);
            const pg8::EpiHeadNorm<1> E{kv ? nullptr : ssq, rstd_mem, kv ? INP(24) : INP(23) + (size_t)li * 256, nullptr, kv ? kvall : T2, kv ? 8192 : DM, kv ? 1 : 0, QSCALE_X, 0};
            pg8::gemm_phase(lds, g, AS, S, E, tid, nullptr, 0, pg8::NoHook(), kv ? nullptr : (const char*)(WR + W_XO), (unsigned)(DM * DM * 2), (unsigned)(bx * (NWAVES * 64) + tid));
            if (!kv) { pg8::Unit u;
                for (int i = 0; S.next(i, u); ++i) att::xattn_unit(lds, T2, kvall, li, u.pm >> 4, u.pn, u.pm & 15, T1, tid); }
        }
        if (kind == K_S5STATE) { PHASE_TID;
            pg8::StaticOrder S; S.init(1024, 16384, G, bx);
            { const pg8::Gemm g{(const bf16_t*)(WR + W_BST), 1024, 16384, 256}; const pg8::ASrcChunk AS{(const char*)T2, 0};
              const pg8::EpiS5State E{(bf16_t*)(BIG + BIG_F)};
              pg8::gemm_phase(lds, g, AS, S, E, tid); }
            { SP_INIT; pg8::Unit u; for (int i = 0; S.next(i, u); ++i) s5_scan_bg(lds, sp, (const bf16_t*)(BIG + BIG_F), (bf16_t*)(BIG + BIG_XB), u.pm, u.pn, tid); }
            asm volatile("s_waitcnt vmcnt(0)" ::: "memory"); __syncthreads();
            { const pg8::Gemm g{(const bf16_t*)(WR + W_BOUT), 1024, 16384, 512}; const pg8::ASrcChunk AS{(const char*)T2, (long)(WS_BIG + BIG_XB) - (long)WS_T2};
              const pg8::EpiS5Out E{T1};
              pg8::gemm_phase(lds, g, AS, S, E, tid); }
        } else if (kind == K_GLU) { PHASE_TID; STAGGER();
            const pg8::Gemm g{(const bf16_t*)(WR + W_GLU), M, 2048, DM}; const pg8::ASrcLinear AS{(const char*)T1, DM};
            pg8::StaticOrder S; S.init(M, 2048, G, bx);
            const pg8::EpiGlu E{hb, ssq};
            pg8::gemm_phase(lds, g, AS, S, E, tid, (const char*)(WR + W_XQ) + (size_t)(bx >> 6) * (256 * DM * 2), DM, pg8::NoHook(), (const char*)(WR + W_XQ), (unsigned)(DM * DM * 2), (unsigned)(bx * (NWAVES * 64) + tid));
        } else if (kind == K_QKV) { PHASE_TID; STAGGER();
            const int gi = (sub - 1) >> 1;
            const pg8::Gemm g{(const bf16_t*)(WR + W_QKV) + (size_t)gi * 3072 * DM, M, 3072, DM}; const pg8::ASrcLinear AS{(const char*)hb, DM};
            pg8::StaticOrder S; S.init(M, 3072, G, bx);
            const pg8::EpiHeadNorm<2> E{ssq, nullptr, INP(18) + (size_t)j * 128, INP(19) + (size_t)j * 128, (bf16_t*)BIG, 3072, 2, QSCALE_DIL, 0};
            { auto hook = [&]() { if (warseam) { XcdBarrier b2 = bar; b2.bar = (unsigned*)(LDP(28) + WS_CTL) + CW_BAR; xcd_wait(b2); } };
              pg8::gemm_phase(lds, g, AS, S, E, tid, nullptr, 0, hook); }
        } else if (kind == K_RES) { PHASE_TID;
            const bf16_t* Bt = sub == 7 ? (const bf16_t*)(WR + W_AO) : (sub == 10 ? (const bf16_t*)(WR + W_XO) : (const bf16_t*)(WR + W_2));
            const int K = sub == 12 ? DFF : DM;
            const pg8::Gemm g{Bt, M, DM, K}; const pg8::ASrcLinear AS{sub == 12 ? (const char*)BIG : (const char*)T1, K};
            pg8::StaticOrder S; S.init(M, DM, G, bx);
            const pg8::EpiRes E{dupdone ? T1 : hb, dupdone ? (float*)T2 : ssq, (li == DEPTH - 1 && sub == 12 && !dupdone) ? out : nullptr};
            pg8::gemm_phase(lds, g, AS, S, E, tid, (sub == 12 || dupdone) ? nullptr : (const char*)(WR + (sub == 7 ? W_XQ : W_1)) + (size_t)(bx >> 6) * (256 * DM * 2), DM, pg8::NoHook(),
                            (sub == 12 || dupdone) ? nullptr : (const char*)(WR + (sub == 7 ? W_XQ : W_1)), sub == 7 ? (unsigned)(DM * DM * 2) : (unsigned)(DM * DFF * 2), (unsigned)(bx * (NWAVES * 64) + tid));
        } else if (kind == K_MLP1) { PHASE_TID; STAGGER();
            const pg8::Gemm g{(const bf16_t*)(WR + W_1), M, DFF, DM}; const pg8::ASrcLinear AS{(const char*)hb, DM};
            pg8::StaticOrder S; S.init(M, DFF, G, bx);
            { const pg8::EpiMlp1 E{ssq, (bf16_t*)BIG};
            pg8::gemm_phase(lds, g, AS, S, E, tid, (const char*)(WR + W_2) + (size_t)(bx >> 6) * (256 * DFF * 2), DFF, pg8::NoHook(), (const char*)(WR + W_2), (unsigned)(DM * DFF * 2), (unsigned)(bx * (NWAVES * 64) + tid)); }
        }
        else if (kind == K_DIL) { PHASE_TID;
            const int gi = (sub - 2) >> 1, ldil = 2 * gi;
            LAS float* btab = (LAS float*)(lds + RING_BYTES);
            for (int u = vcu; u < 512; u += G) { const int x = u & 15, bh = u >> 4, h = bh & 7;
                int tu = tid; asm volatile("" : "+v"(tu));
                if (tu < 192) { const int jk = tu - 32; btab[tu] = (jk >= 0 && jk <= 128) ? biasrel[(gi * 8 + h) * 129 + jk] : -1e30f; }
                att::dil_unit(lds, btab, (const bf16_t*)BIG, gi, ldil, bh >> 3, h, x & ((1 << ldil) - 1), x >> ldil, T1, (float*)(wsb + WS_MISC + 65536), tu); }
        }
#ifdef DUP_KIND
        if (kind == DUP_KIND && (DUP_SUB < 0 || sub == DUP_SUB) && (DUP_LI < 0 || li == DUP_LI) && !dupdone) { dupdone = true; --ph; } else dupdone = false;
#endif
    }
}
#undef out
#undef ssq
#undef rstd_mem
#undef biasrel
#undef hb
#undef kvall
#undef memb
#undef T1
#undef T2
#undef BIG
#undef WR
#undef SP_INIT
#undef PHASE_TID
#undef LDP
#undef INP
extern "C" void kernel_launch(void* const* d_in, const int* in_sizes, int n_in, void* d_out, int out_size, void* d_ws, size_t ws_size, hipStream_t stream) {
    static int grid = 0;
    if (grid == 0) {
        if (n_in != 27 || ws_size < WS_END || in_sizes[0] != M * DM || out_size != M * DM) { fprintf(stderr, "kernel_launch: unexpected n_in %d / ws %zu\n", n_in, ws_size); grid = -1; return; }
        int dev = 0, cus = 0;
        if (hipGetDevice(&dev) != hipSuccess || hipDeviceGetAttribute(&cus, hipDeviceAttributeMultiprocessorCount, dev) != hipSuccess) { grid = -1; return; }
        if (hipFuncSetAttribute((const void*)mk_fwd, hipFuncAttributeMaxDynamicSharedMemorySize, LDS_BYTES) != hipSuccess) { fprintf(stderr, "kernel_launch: hipFuncSetAttribute failed\n"); grid = -1; return; }
        int nb = 0;
        if (hipOccupancyMaxActiveBlocksPerMultiprocessor(&nb, mk_fwd, NWAVES * 64, (size_t)LDS_BYTES) != hipSuccess || nb < 1) { fprintf(stderr, "kernel_launch: occupancy query failed (%d)\n", nb); grid = -1; return; }
        grid = cus;
    }
    if (grid < 0) return;
    float* out = (float*)d_out; unsigned char* ws = (unsigned char*)d_ws;
    Args a{};
    for (int i = 0; i < 27; ++i) a.in[i] = (const float*)d_in[i];
    a.out = out; a.ws = ws;
    auto fast = [&](int lo, int hi) {
        (void)hipMemsetAsync(ws + WS_CTL, 0, 65536, stream);
        a.ph_lo = lo; a.ph_hi = hi;
        hipLaunchKernelGGL(mk_fwd, dim3(grid), dim3(NWAVES * 64), LDS_BYTES, stream, a);
    };

    fast(0, DEPTH * 16);
}
```

```cpp
#include <hip/hip_runtime.h>
#include <cstdint>
#include <cstdio>

typedef unsigned short bf16_t;
typedef unsigned u32x4 __attribute__((ext_vector_type(4)));
typedef unsigned u32x2 __attribute__((ext_vector_type(2)));
typedef float f32x4 __attribute__((ext_vector_type(4)));

constexpr int BATCH = 4, SEQ = 4096, DM = 1024, M = BATCH * SEQ, DEPTH = 4;
constexpr int MEMLEN = 256, MROWS = BATCH * MEMLEN;
constexpr int DFF = 4096;
constexpr float EPS = 1e-6f;
constexpr float LOG2E = 1.4426950408889634f;
constexpr float QSCALE_DIL = 0.08838834764831845f * LOG2E;
constexpr float QSCALE_X = 0.0625f * LOG2E;

constexpr size_t MiB = 1u << 20;
constexpr size_t WS_CTL = 0;
constexpr size_t WS_MISC = 1 * MiB;
constexpr size_t WS_SSQ = 2 * MiB;
constexpr size_t WS_HB = 4 * MiB;
constexpr size_t WS_KV = 36 * MiB;
constexpr size_t WS_MEMB = 52 * MiB;
constexpr size_t WS_T1 = 54 * MiB;
constexpr size_t WS_T2 = 86 * MiB;
constexpr size_t WS_BIG = 118 * MiB;
constexpr size_t WS_W = 246 * MiB;
constexpr size_t WS_END = 342 * MiB;

__device__ __forceinline__ float bf2f(bf16_t v) { return __uint_as_float((unsigned)v << 16); }
__device__ __forceinline__ unsigned f2bf(float f) { unsigned u = __float_as_uint(f); return (u + 0x7fffu + ((u >> 16) & 1u)) >> 16; }
__device__ __forceinline__ unsigned pk2(float lo, float hi) { return f2bf(lo) | (f2bf(hi) << 16); }

namespace pg8 {
#define PG8_LAS __attribute__((address_space(3)))
typedef short bf16x8 __attribute__((ext_vector_type(8)));
constexpr int BM = 256, BK = 64, HALF = 128, HTB = HALF * BK * 2  , STAGE_BYTES = 8 * HTB, NXCD = 8, WGM = 8;
constexpr int XCH_OFF = STAGE_BYTES;

__host__ __device__ __forceinline__ int lds_byte(int r, int c) { const int st = (r >> 4) * 2 + (c >> 5), rr = r & 15, cc = c & 31, ob = rr * 64 + cc * 2; return st * 1024 + (ob ^ (((ob >> 9) & 1) << 5)); }
__host__ __device__ __forceinline__ void stage_rc(int b, int& R, int& C) { const int st = b / 1024, sb = b % 1024, swz = sb ^ (((sb >> 9) & 1) << 5); R = (st >> 1) * 16 + swz / 64; C = (st & 1) * 32 + (swz % 64) / 2; }
__host__ __device__ __forceinline__ int perm32(int rho) { const int n = rho >> 4, i = rho & 15; return 8 * (i >> 2) + 4 * n + (i & 3); }

struct Unit { int pm, pn; };
struct StaticOrder {
    int nM, nN, nwg, G, c;
    __device__ void init(int M_, int N_, int G_, int c_) { nM = M_ / BM; nN = N_ / BM; nwg = nM * nN; G = G_; c = c_; }
    __device__ bool next(int i, Unit& u) const {
        const long L = (long)i * G + c; if (L >= nwg) return false;
        int wgid = (int)L; { const int q = nwg / NXCD, r = nwg % NXCD, xcd = wgid % NXCD, off = wgid / NXCD; wgid = (xcd < r ? xcd * (q + 1) : r * (q + 1) + (xcd - r) * q) + off; }
        const int nig = WGM * nN, gid = wgid / nig, fm = gid * WGM, gsz = (nM - fm) < WGM ? (nM - fm) : WGM;
        u.pm = fm + ((wgid % nig) % gsz); u.pn = (wgid % nig) / gsz; return true;
    }
};

struct ASrcLinear {
    const char* A; int K;
    __device__ __forceinline__ unsigned voff(int R, int C) const { return (unsigned)(R * K + C) * 2u; }
    __device__ __forceinline__ size_t hstep() const { return (size_t)HALF * K * 2; }
    __device__ __forceinline__ const char* tile(const Unit& u, int t) const { return A + (size_t)u.pm * 2 * hstep() + (size_t)t * (BK * 2); }
};
struct ASrcChunk {
    const char* U; long xoff;
    __device__ __forceinline__ unsigned voff(int R, int C) const { return (unsigned)(R * 256 + C) * 2u; }
    __device__ __forceinline__ size_t hstep() const { return (size_t)HALF * 512; }
    __device__ __forceinline__ const char* tile(const Unit& u, int t) const { return U + (long)(t >> 2) * xoff + (size_t)u.pn * (1024 * 512) + (size_t)u.pm * 2 * hstep() + (size_t)(t & 3) * (BK * 2); }
};
struct Gemm { const bf16_t* Bt; int M, N, K; };

__device__ __forceinline__ unsigned cvt_pk_bf16(float lo, float hi) { unsigned r; asm volatile("v_cvt_pk_bf16_f32 %0, %1, %2" : "=v"(r) : "v"(lo), "v"(hi)); return r; }
__device__ __forceinline__ float shx(float v, int lane, int mask) { return __builtin_bit_cast(float, __builtin_amdgcn_ds_bpermute((lane ^ mask) << 2, __builtin_bit_cast(int, v))); }
#define PG8_XBAR() do { asm volatile("s_waitcnt lgkmcnt(0)" ::: "memory"); __builtin_amdgcn_s_barrier(); asm volatile("" ::: "memory"); } while (0)

constexpr int RSTD_OFF = STAGE_BYTES + 8192 + 1024;
__device__ __forceinline__ void rstd_panel_to_lds(PG8_LAS unsigned char* lds, const float* ssq, int pm, int tid) {
    const int row = tid >> 1, hf = tid & 1, lane = tid & 63;
    const f32x4* p = (const f32x4*)(ssq + (size_t)(pm * BM + row) * 32 + hf * 16);
    const f32x4 a = p[0], b = p[1], c = p[2], d = p[3];
    float s = (((a.x + a.y) + (a.z + a.w)) + ((b.x + b.y) + (b.z + b.w))) + (((c.x + c.y) + (c.z + c.w)) + ((d.x + d.y) + (d.z + d.w)));
    s += shx(s, lane, 1);
    if (hf == 0) ((PG8_LAS float*)(lds + RSTD_OFF))[row] = rsqrtf(s * (1.0f / 1024.f) + 1e-6f);
}
__device__ __forceinline__ void rstd_from_lds(PG8_LAS unsigned char* lds, int wr, int fr, float (&rs)[2][4]) {
#pragma unroll
    for (int ai = 0; ai < 2; ++ai)
#pragma unroll
        for (int m = 0; m < 4; ++m) rs[ai][m] = ((const PG8_LAS float*)(lds + RSTD_OFF))[ai * HALF + wr * 64 + m * 16 + fr];
}
typedef f32x4 AccT[2][2][4][2];

__device__ __forceinline__ f32x4 bf_lo4(unsigned a, unsigned b) { return (f32x4){__uint_as_float(a << 16), __uint_as_float(a & 0xffff0000u), __uint_as_float(b << 16), __uint_as_float(b & 0xffff0000u)}; }
struct EpiRes {
    static constexpr bool PERM = true, AFTER_DRAIN = false;
    bf16_t* hb; float* ssq; float* fout;
    __device__ __forceinline__ void prologue(const Unit&, PG8_LAS unsigned char*, int) const {}
    __device__ __forceinline__ void operator()(AccT& acc, const Unit& u, int wr, int wc, int fr, int fq, PG8_LAS unsigned char*) const {
        const int col0 = u.pn * BM + wc * 32 + 8 * fq, lane = fr + 16 * fq;
        const int row0 = u.pm * BM + wr * 64 + fr;
        const unsigned e0 = (unsigned)row0 * 1024u + (unsigned)col0;
        const char* hbc = (const char*)hb;
        u32x4 bs[2][4][2];
#pragma unroll
        for (int ai = 0; ai < 2; ++ai)
#pragma unroll
            for (int m = 0; m < 4; ++m) { const unsigned e = e0 + (unsigned)((ai * HALF + m * 16) * 1024);
                bs[ai][m][0] = *(const u32x4*)(hbc + (e * 2u)); bs[ai][m][1] = *(const u32x4*)(hbc + ((e + HALF) * 2u)); }
#pragma unroll
        for (int ai = 0; ai < 2; ++ai) {
#pragma unroll
            for (int m = 0; m < 4; ++m) { const int row = row0 + ai * HALF + m * 16; const unsigned e = e0 + (unsigned)((ai * HALF + m * 16) * 1024);
#pragma unroll
                for (int bj = 0; bj < 2; ++bj) { const u32x4 bb = bs[ai][m][bj];
                    const f32x4 v0 = acc[ai][bj][m][0] + bf_lo4(bb.x, bb.y), v1 = acc[ai][bj][m][1] + bf_lo4(bb.z, bb.w);
                    u32x4 w; w.x = cvt_pk_bf16(v0.x, v0.y); w.y = cvt_pk_bf16(v0.z, v0.w); w.z = cvt_pk_bf16(v1.x, v1.y); w.w = cvt_pk_bf16(v1.z, v1.w);
                    if (fout) { float* fo = (float*)((char*)fout + (size_t)(e + bj * HALF) * 4u); *(f32x4*)fo = v0; *(f32x4*)(fo + 4) = v1; }
                    else {
                        *(u32x4*)((char*)hb + ((e + bj * HALF) * 2u)) = w;
                        float ss = ((v0.x * v0.x + v0.y * v0.y) + (v0.z * v0.z + v0.w * v0.w)) + ((v1.x * v1.x + v1.y * v1.y) + (v1.z * v1.z + v1.w * v1.w));
                        ss += shx(ss, lane, 16); ss += shx(ss, lane, 32);
                        if (fq == 0) ssq[(size_t)row * 32 + u.pn * 8 + bj * 4 + wc] = ss; } } }
            asm volatile("" ::: "memory"); }
    }
};
struct EpiGlu {
    static constexpr bool PERM = true, AFTER_DRAIN = false;
    bf16_t* hb; float* ssq;
    __device__ __forceinline__ void prologue(const Unit&, PG8_LAS unsigned char*, int) const {}
    __device__ __forceinline__ void operator()(AccT& acc, const Unit& u, int wr, int wc, int fr, int fq, PG8_LAS unsigned char*) const {
        const int col0 = u.pn * HALF + wc * 32 + 8 * fq, lane = fr + 16 * fq;
        u32x4 bs[2][4];
#pragma unroll
        for (int ai = 0; ai < 2; ++ai)
#pragma unroll
            for (int m = 0; m < 4; ++m) bs[ai][m] = *(const u32x4*)(hb + (size_t)(u.pm * BM + ai * HALF + wr * 64 + m * 16 + fr) * 1024 + col0);
#pragma unroll
        for (int ai = 0; ai < 2; ++ai)
#pragma unroll
            for (int m = 0; m < 4; ++m) { const int row = u.pm * BM + ai * HALF + wr * 64 + m * 16 + fr; const size_t off = (size_t)row * 1024 + col0;
                const u32x4 bb = bs[ai][m];
                f32x4 v0 = bf_lo4(bb.x, bb.y), v1 = bf_lo4(bb.z, bb.w);
                const f32x4 a0 = acc[ai][0][m][0], a1 = acc[ai][0][m][1], g0 = acc[ai][1][m][0], g1 = acc[ai][1][m][1];
#pragma unroll
                for (int j = 0; j < 4; ++j) { v0[j] += a0[j] * __builtin_amdgcn_rcpf(1.f + __builtin_amdgcn_exp2f(-1.4426950408889634f * g0[j]));
                                              v1[j] += a1[j] * __builtin_amdgcn_rcpf(1.f + __builtin_amdgcn_exp2f(-1.4426950408889634f * g1[j])); }
                u32x4 w; w.x = cvt_pk_bf16(v0.x, v0.y); w.y = cvt_pk_bf16(v0.z, v0.w); w.z = cvt_pk_bf16(v1.x, v1.y); w.w = cvt_pk_bf16(v1.z, v1.w);
                *(u32x4*)(hb + off) = w;
                float ss = ((v0.x * v0.x + v0.y * v0.y) + (v0.z * v0.z + v0.w * v0.w)) + ((v1.x * v1.x + v1.y * v1.y) + (v1.z * v1.z + v1.w * v1.w));
                ss += shx(ss, lane, 16); ss += shx(ss, lane, 32);
                if (fq == 0) ssq[(size_t)row * 32 + u.pn * 4 + wc] = ss; }
    }
};
struct EpiMlp1 {
    static constexpr bool PERM = true, AFTER_DRAIN = false;
    const float* ssq; bf16_t* out;
    __device__ __forceinline__ void prologue(const Unit& u, PG8_LAS unsigned char* lds, int tid) const { rstd_panel_to_lds(lds, ssq, u.pm, tid); }
    __device__ __forceinline__ void operator()(AccT& acc, const Unit& u, int wr, int wc, int fr, int fq, PG8_LAS unsigned char* lds) const {
        const int rowbase = u.pm * BM + wr * 64 + fr, col0 = u.pn * BM + wc * 32 + 8 * fq;
        float rs[2][4]; rstd_from_lds(lds, wr, fr, rs);
#pragma unroll
        for (int ai = 0; ai < 2; ++ai)
#pragma unroll
            for (int m = 0; m < 4; ++m) { bf16_t* rowp = out + (size_t)(rowbase + ai * HALF + m * 16) * 4096 + col0; const float r = rs[ai][m];
#pragma unroll
                for (int bj = 0; bj < 2; ++bj) { f32x4 v0 = acc[ai][bj][m][0] * r, v1 = acc[ai][bj][m][1] * r;
#pragma unroll
                    for (int j = 0; j < 4; ++j) { v0[j] = fmaxf(v0[j], 0.f); v0[j] *= v0[j]; v1[j] = fmaxf(v1[j], 0.f); v1[j] *= v1[j]; }
                    u32x4 w; w.x = cvt_pk_bf16(v0[0], v0[1]); w.y = cvt_pk_bf16(v0[2], v0[3]); w.z = cvt_pk_bf16(v1[0], v1[1]); w.w = cvt_pk_bf16(v1[2], v1[3]);
                    *(u32x4*)(rowp + bj * HALF) = w; } }
    }
};
template <int NSEG> struct EpiHeadNorm {
    static constexpr bool PERM = true, AFTER_DRAIN = false;
    const float* ssq;
    const float* rowscale;
    const float* gain0; const float* gain1;
    bf16_t* out; int ldc; int mode; float sc0; int pad;
    __device__ __forceinline__ void prologue(const Unit& u, PG8_LAS unsigned char* lds, int tid) const { if (ssq) rstd_panel_to_lds(lds, ssq, u.pm, tid); }
    __device__ __forceinline__ void operator()(AccT& acc, const Unit& u, int wr, int wc, int fr, int fq, PG8_LAS unsigned char* lds) const {
        const int rowbase = u.pm * BM + wr * 64 + fr, col0 = u.pn * BM + wc * 32 + 8 * fq;
        bool normed; const float* g; float psc = 1.f;
        if (mode == 0) { normed = true; g = gain0; psc = sc0; }
        else if (mode == 1) { normed = (u.pn & 7) < 4; g = gain0 + 256 * (u.pn >> 3); }
        else { const int which = u.pn >> 2; normed = which < 2; g = which == 0 ? gain0 : gain1; psc = which == 0 ? sc0 : 1.f; }
        f32x4 gv[2][2];
#pragma unroll
        for (int bj = 0; bj < 2; ++bj)
#pragma unroll
            for (int n = 0; n < 2; ++n) gv[bj][n] = normed ? *(const f32x4*)(g + (NSEG == 1 ? bj * HALF : 0) + wc * 32 + 8 * fq + 4 * n) : (f32x4){1.f, 1.f, 1.f, 1.f};
        float rs[2][4];
        if (ssq) rstd_from_lds(lds, wr, fr, rs);
        else {
#pragma unroll
            for (int ai = 0; ai < 2; ++ai)
#pragma unroll
                for (int m = 0; m < 4; ++m) rs[ai][m] = rowscale[rowbase + ai * HALF + m * 16];
        }
        float rn[2][4][2];
        if (normed) {
            PG8_LAS float* P = (PG8_LAS float*)(lds + XCH_OFF);
#pragma unroll
            for (int ai = 0; ai < 2; ++ai)
#pragma unroll
                for (int m = 0; m < 4; ++m) { float s[2];
#pragma unroll
                    for (int bj = 0; bj < 2; ++bj) { const f32x4 a = acc[ai][bj][m][0], b = acc[ai][bj][m][1];
                        s[bj] = ((a.x * a.x + a.y * a.y) + (a.z * a.z + a.w * a.w)) + ((b.x * b.x + b.y * b.y) + (b.z * b.z + b.w * b.w)); }
                    if (NSEG == 1) { s[0] += s[1]; s[1] = 0.f; }
#pragma unroll
                    for (int sg = 0; sg < NSEG; ++sg) { float t = s[sg]; t += shx(t, fr + 16 * fq, 16); t += shx(t, fr + 16 * fq, 32);
                        if (fq == 0) P[((ai * HALF + wr * 64 + m * 16 + fr) * 2 + sg) * 4 + wc] = t; } }
            PG8_XBAR();
#pragma unroll
            for (int ai = 0; ai < 2; ++ai)
#pragma unroll
                for (int m = 0; m < 4; ++m)
#pragma unroll
                    for (int sg = 0; sg < NSEG; ++sg) { const f32x4 t = *(const PG8_LAS f32x4*)(P + ((ai * HALF + wr * 64 + m * 16 + fr) * 2 + sg) * 4);
                        const float r0 = rs[ai][m]; rn[ai][m][sg] = rsqrtf(((t.x + t.y) + (t.z + t.w)) * (r0 * r0) * (NSEG == 1 ? 1.0f / 256.f : 1.0f / 128.f) + 1e-6f) * (psc * r0); }
        }
#pragma unroll
        for (int ai = 0; ai < 2; ++ai)
#pragma unroll
            for (int m = 0; m < 4; ++m) { bf16_t* rowp = out + (size_t)(rowbase + ai * HALF + m * 16) * ldc + col0;
#pragma unroll
                for (int bj = 0; bj < 2; ++bj) { const float r = normed ? rn[ai][m][NSEG == 1 ? 0 : bj] : rs[ai][m];
                    const f32x4 v0 = acc[ai][bj][m][0] * gv[bj][0] * r, v1 = acc[ai][bj][m][1] * gv[bj][1] * r;
                    u32x4 w; w.x = cvt_pk_bf16(v0[0], v0[1]); w.y = cvt_pk_bf16(v0[2], v0[3]); w.z = cvt_pk_bf16(v1[0], v1[1]); w.w = cvt_pk_bf16(v1[2], v1[3]);
                    *(u32x4*)(rowp + bj * HALF) = w; } }
    }
};
struct EpiS5State {
    static constexpr bool PERM = true, AFTER_DRAIN = false;
    bf16_t* F;
    __device__ __forceinline__ void prologue(const Unit&, PG8_LAS unsigned char*, int) const {}
    __device__ __forceinline__ void operator()(AccT& acc, const Unit& u, int wr, int wc, int fr, int fq, PG8_LAS unsigned char*) const {
        const int col0 = wc * 32 + 8 * fq;
#pragma unroll
        for (int ai = 0; ai < 2; ++ai)
#pragma unroll
            for (int m = 0; m < 4; ++m) { bf16_t* rowp = F + ((size_t)u.pn * 1024 + u.pm * BM + ai * HALF + wr * 64 + m * 16 + fr) * 256 + col0;
#pragma unroll
                for (int bj = 0; bj < 2; ++bj) { const f32x4 v0 = acc[ai][bj][m][0], v1 = acc[ai][bj][m][1];
                    u32x4 w; w.x = cvt_pk_bf16(v0[0], v0[1]); w.y = cvt_pk_bf16(v0[2], v0[3]); w.z = cvt_pk_bf16(v1[0], v1[1]); w.w = cvt_pk_bf16(v1[2], v1[3]);
                    *(u32x4*)(rowp + bj * HALF) = w; } }
    }
};
__device__ __forceinline__ float gelu_tanh_fast(float x) {
    const float z2 = 2.302208198f * (x + 0.044715f * x * x * x);
    const float e = __builtin_amdgcn_exp2f(z2);
    return x - x * __builtin_amdgcn_rcpf(1.f + e);
}
struct EpiS5Out {
    static constexpr bool PERM = true, AFTER_DRAIN = false;
    bf16_t* G;
    __device__ __forceinline__ void prologue(const Unit&, PG8_LAS unsigned char*, int) const {}
    __device__ __forceinline__ void operator()(AccT& acc, const Unit& u, int wr, int wc, int fr, int fq, PG8_LAS unsigned char*) const {
#pragma unroll
        for (int ai = 0; ai < 2; ++ai)
#pragma unroll
            for (int m = 0; m < 4; ++m) { const int crow = u.pm * BM + ai * HALF + wr * 64 + m * 16 + fr;
#pragma unroll
                for (int bj = 0; bj < 2; ++bj) { const int c = bj * HALF + wc * 32 + 8 * fq, s = c >> 4, ch0 = c & 15;
                    f32x4 v0 = acc[ai][bj][m][0], v1 = acc[ai][bj][m][1];
#pragma unroll
                    for (int j = 0; j < 4; ++j) { v0[j] = gelu_tanh_fast(v0[j]); v1[j] = gelu_tanh_fast(v1[j]); }
                    u32x4 w; w.x = cvt_pk_bf16(v0[0], v0[1]); w.y = cvt_pk_bf16(v0[2], v0[3]); w.z = cvt_pk_bf16(v1[0], v1[1]); w.w = cvt_pk_bf16(v1[2], v1[3]);
                    *(u32x4*)(G + ((size_t)crow * 16 + s) * 1024 + u.pn * 16 + ch0) = w; } }
    }
};

struct NoHook { __device__ __forceinline__ void operator()() const {} };
template <class Epi, class ASrc, class Hook = NoHook>
__device__ __forceinline__ void gemm_phase(PG8_LAS unsigned char* lds, const Gemm g, const ASrc AS, const StaticOrder& S, const Epi& E, const int tid  ,
                                           const char* warm = nullptr  , int wK = 0, const Hook& hook = Hook(),
                                           const char* wmat = nullptr  , unsigned wbytes = 0, unsigned gtid = 0  ) {
    const int wid = __builtin_amdgcn_readfirstlane(tid >> 6), lane = tid & 63, wr = wid >> 2, wc = wid & 3, fr = lane & 15, fq = lane >> 4;
    const int K = g.K, nt = K / BK;
    unsigned voffA[2], voffB[2];
#pragma unroll
    for (int i = 0; i < 2; ++i) { int R, C; stage_rc(tid * 16 + i * 8192, R, C); const int Rb = Epi::PERM ? ((R & ~31) + perm32(R & 31)) : R;
        voffA[i] = AS.voff(R, C); voffB[i] = (unsigned)(Rb * K + C) * 2u; }
    const size_t kstep = (size_t)(BK * 2);
    const size_t hstepB = (size_t)HALF * K * 2, hstepA = AS.hstep();
    const unsigned ldsw = (unsigned)wid * 1024u;
    const int aoff = lds_byte(wr * 64 + fr, fq * 8), boff = lds_byte(wc * 32 + fr, fq * 8);
#define PG8_SA(b, h) (((b) * 2 + (h)) * HTB)
#define PG8_SB(b, h) ((4 + (b) * 2 + (h)) * HTB)
#define PG8_STAGE(bufoff, gbase, voff) do { _Pragma("unroll") for (int _i = 0; _i < 2; ++_i) \
        __builtin_amdgcn_global_load_lds((const unsigned*)((const char*)(gbase) + (voff)[_i]), (PG8_LAS unsigned*)(lds + (bufoff) + ldsw + _i * 8192), 16, 0, 0); } while (0)
#define PG8_LDA(dst, b, h) do { _Pragma("unroll") for (int m = 0; m < 4; ++m) _Pragma("unroll") for (int k = 0; k < 2; ++k) dst[m][k] = *(const PG8_LAS bf16x8*)(lds + PG8_SA(b, h) + aoff + m * 2048 + k * 1024); } while (0)
#define PG8_LDB(dst, b, h) do { _Pragma("unroll") for (int n = 0; n < 2; ++n) _Pragma("unroll") for (int k = 0; k < 2; ++k) dst[n][k] = *(const PG8_LAS bf16x8*)(lds + PG8_SB(b, h) + boff + n * 2048 + k * 1024); } while (0)
#define PG8_MMA(ai, bj, At, Bt) do { __builtin_amdgcn_s_setprio(1); _Pragma("unroll") for (int m = 0; m < 4; ++m) _Pragma("unroll") for (int n = 0; n < 2; ++n) _Pragma("unroll") for (int k = 0; k < 2; ++k) \
        acc[ai][bj][m][n] = __builtin_amdgcn_mfma_f32_16x16x32_bf16(Bt[n][k], At[m][k], acc[ai][bj][m][n], 0, 0, 0); __builtin_amdgcn_s_setprio(0); } while (0)
#define PG8_WAIT_V(n) asm volatile("s_waitcnt vmcnt(" #n ")" ::: "memory")
#define PG8_WAIT_L(n) asm volatile("s_waitcnt lgkmcnt(" #n ")" ::: "memory")
#define PG8_BAR __builtin_amdgcn_s_barrier()
#define PG8_SCHED __builtin_amdgcn_sched_barrier(0)
    Unit cur, nxt; int ui = 0; unsigned warmv = 0u, warmm = 0u;
    if (!S.next(0, cur)) return;
    AccT acc;
#pragma unroll
    for (int a = 0; a < 2; ++a)
#pragma unroll
        for (int b = 0; b < 2; ++b)
#pragma unroll
            for (int m = 0; m < 4; ++m)
#pragma unroll
                for (int n = 0; n < 2; ++n) acc[a][b][m][n] = (f32x4){0.f, 0.f, 0.f, 0.f};
    bf16x8 At[4][2], B0[2][2], B1[2][2];
    const char* cB = (const char*)g.Bt + (size_t)cur.pn * 2 * hstepB;
    { const char* cA0 = AS.tile(cur, 0); const char* cA1 = AS.tile(cur, 1);
      PG8_STAGE(PG8_SB(0, 0), cB, voffB); PG8_STAGE(PG8_SB(0, 1), cB + hstepB, voffB); PG8_STAGE(PG8_SA(0, 0), cA0, voffA); PG8_STAGE(PG8_SA(0, 1), cA0 + hstepA, voffA);
      PG8_STAGE(PG8_SB(1, 0), cB + kstep, voffB); PG8_STAGE(PG8_SA(1, 0), cA1, voffA); PG8_STAGE(PG8_SB(1, 1), cB + hstepB + kstep, voffB);
      E.prologue(cur, lds, tid);
      if (wr == 1) PG8_BAR;
      PG8_WAIT_V(8); PG8_BAR;
      PG8_WAIT_V(6); PG8_BAR; }
    for (;;) {
        const bool has_next = S.next(ui + 1, nxt);
        const Unit nu = has_next ? nxt : cur;
        const char* nB = (const char*)g.Bt + (size_t)nu.pn * 2 * hstepB;
#pragma unroll 1
        for (int t = 0; t < nt; t += 2) {
            const bool last = (t == nt - 2);
            const char* a1 = AS.tile(cur, t + 1);
            const char* a2 = last ? AS.tile(nu, 0) : AS.tile(cur, t + 2); const char* b2 = last ? nB : cB + (size_t)(t + 2) * kstep;
            const char* a3 = last ? AS.tile(nu, 1) : AS.tile(cur, t + 3); const char* b3 = b2 + kstep;
            PG8_LDB(B0, 0, 0); PG8_LDB(B1, 0, 1); PG8_SCHED; PG8_LDA(At, 0, 0); PG8_STAGE(PG8_SA(1, 1), a1 + hstepA, voffA);
            PG8_WAIT_V(8); PG8_WAIT_L(0); PG8_BAR; PG8_MMA(0, 0, At, B0); PG8_MMA(0, 1, At, B1); PG8_BAR; PG8_SCHED;
            PG8_LDA(At, 0, 1); PG8_STAGE(PG8_SB(0, 0), b2, voffB); PG8_STAGE(PG8_SB(0, 1), b2 + hstepB, voffB); PG8_STAGE(PG8_SA(0, 0), a2, voffA);
            PG8_WAIT_V(8); PG8_WAIT_L(0); PG8_BAR; PG8_MMA(1, 0, At, B0); PG8_MMA(1, 1, At, B1); PG8_BAR; PG8_SCHED;
            PG8_LDB(B0, 1, 0); PG8_LDB(B1, 1, 1); PG8_SCHED; PG8_LDA(At, 1, 0); PG8_STAGE(PG8_SA(0, 1), a2 + hstepA, voffA);
            PG8_WAIT_V(8); PG8_WAIT_L(0); PG8_BAR; PG8_MMA(0, 0, At, B0); PG8_MMA(0, 1, At, B1); PG8_BAR; PG8_SCHED;
            PG8_LDA(At, 1, 1); PG8_STAGE(PG8_SB(1, 0), b3, voffB); PG8_STAGE(PG8_SB(1, 1), b3 + hstepB, voffB); PG8_STAGE(PG8_SA(1, 0), a3, voffA);
            PG8_WAIT_V(8); PG8_WAIT_L(0); PG8_BAR; PG8_MMA(1, 0, At, B0); PG8_MMA(1, 1, At, B1); PG8_BAR; PG8_SCHED;
        }
        if (wr == 0) PG8_BAR;
        if (!has_next && wmat && gtid * 128u < wbytes) asm volatile("global_load_dword %0, %1, off" : "+v"(warmm) : "v"(wmat + (size_t)gtid * 128u) : "memory");
        if (!has_next && warm) warmv = *(const volatile unsigned*)(warm + ((size_t)(tid & 255) * wK + (size_t)(tid >> 8) * BK) * 2);
        if (ui == 0) hook();
        E(acc, cur, wr, wc, fr, fq, lds);
        if (!has_next) break;
#pragma unroll
        for (int a = 0; a < 2; ++a)
#pragma unroll
            for (int b = 0; b < 2; ++b)
#pragma unroll
                for (int m = 0; m < 4; ++m)
#pragma unroll
                    for (int n = 0; n < 2; ++n) acc[a][b][m][n] = (f32x4){0.f, 0.f, 0.f, 0.f};
        cur = nxt; cB = nB; ++ui;
        if (wr == 1) PG8_BAR;
    }
    PG8_WAIT_V(0);
    asm volatile("" :: "v"(warmv), "v"(warmm));
    PG8_BAR;
#undef PG8_SA
#undef PG8_SB
#undef PG8_STAGE
#undef PG8_LDA
#undef PG8_LDB
#undef PG8_MMA
#undef PG8_WAIT_V
#undef PG8_WAIT_L
#undef PG8_BAR
#undef PG8_SCHED
}
}
constexpr int NWAVES = 8;
constexpr int RING_BYTES = 131072;
constexpr int XCH_BYTES = 8192;
constexpr int MISC_OFF = RING_BYTES + XCH_BYTES;
constexpr int LDS_BYTES = 147456;

constexpr size_t W_XQ = 0, W_XO = 2 * MiB, W_1 = 4 * MiB, W_2 = 12 * MiB, W_MIX = 20 * MiB;
constexpr size_t W_GLU = W_MIX, W_BST = W_MIX + 4 * MiB, W_BOUT = W_MIX + 12 * MiB;
constexpr size_t W_QKV = W_MIX + 28 * MiB, W_AO = W_MIX + 46 * MiB;
constexpr size_t BIG_F = 0, BIG_XB = 64 * MiB, BIG_WKV = 96 * MiB;
constexpr int CW_BAR = 4096;

#define GAS __attribute__((address_space(1)))
#define LAS __attribute__((address_space(3)))
typedef GAS unsigned gu32;
#define RLX_AGENT __ATOMIC_RELAXED, __HIP_MEMORY_SCOPE_AGENT
#define LDS_WAIT() asm volatile("s_waitcnt lgkmcnt(0)" ::: "memory")

__device__ __forceinline__ int tid_here(int wave) { int z = 0; asm volatile("" : "+v"(z)); return wave * 64 + (int)__builtin_amdgcn_mbcnt_hi(~0u, __builtin_amdgcn_mbcnt_lo(~0u, (unsigned)z)); }
#define XB_TMO      128
#define XB_XCNT(j)  (256  + 64 * (j))
#define XB_XSUB(j)  (1280 + 64 * (j))
#define XB_XGEN(j)  (2304 + 64 * (j))
#define XB_TOP      3328
#define XB_TOPGEN   3392
#define XB_NLOCAL   3424
#define XB_XCCID    3456
#define XCD_BAR_WORDS 4096
#define XB_SPIN_CAP (1u << 22)
__device__ __forceinline__ unsigned xb_ld(unsigned* p)              { return __hip_atomic_load(p, __ATOMIC_RELAXED, __HIP_MEMORY_SCOPE_AGENT); }
__device__ __forceinline__ unsigned xb_add(unsigned* p, unsigned v) { return __hip_atomic_fetch_add(p, v, __ATOMIC_RELAXED, __HIP_MEMORY_SCOPE_AGENT); }
__device__ __forceinline__ unsigned xb_xcc_id() { return (unsigned)__builtin_amdgcn_s_getreg((3 << 11) | 20) & 0xFu; }
#define XB_SPIN(cond, bar) do { unsigned _sp = 0; while (cond) { __builtin_amdgcn_s_sleep(1); \
    if ((++_sp & 255u) == 0u) { if (xb_ld(&(bar)[XB_TMO])) break; if (_sp > XB_SPIN_CAP) { atomicAdd(&(bar)[XB_TMO], 1u); break; } } } } while (0)
struct XcdBarrier { unsigned* bar; unsigned x; volatile LAS unsigned* st; int wave; };
__device__ __forceinline__ XcdBarrier xcd_barrier_post(unsigned* bar, volatile LAS unsigned* st) {
    XcdBarrier b; b.bar = bar; b.x = xb_xcc_id(); b.st = st; b.wave = __builtin_amdgcn_readfirstlane((int)threadIdx.x >> 6);
    if (threadIdx.x == 0) { (void)xb_add(&bar[XB_XCNT(b.x)], 1u); __hip_atomic_store(&bar[XB_XCCID + blockIdx.x], b.x + 1u, __ATOMIC_RELAXED, __HIP_MEMORY_SCOPE_AGENT); }
    return b;
}
__device__ __forceinline__ void xcd_barrier_complete(unsigned* bar, unsigned x, unsigned& nloc, unsigned& nx) {
    const unsigned G = gridDim.x * gridDim.y * gridDim.z;
    unsigned sum, cnt, mine, sp = 0u;
    for (;;) {
        sum = 0u; cnt = 0u; mine = 0u;
#pragma unroll
        for (unsigned j = 0; j < 16; ++j) { const unsigned c = xb_ld(&bar[XB_XCNT(j)]); sum += c; cnt += (c > 0u) ? 1u : 0u; mine = (j == x) ? c : mine; }
        if (sum == G) break;
        __builtin_amdgcn_s_sleep(1);
        if ((++sp & 255u) == 0u) { if (xb_ld(&bar[XB_TMO])) break; if (sp > XB_SPIN_CAP) { atomicAdd(&bar[XB_TMO], 1u); break; } }
    }
    nloc = mine > 0u ? mine : 1u; nx = cnt > 0u ? cnt : 1u;
}
__device__ __forceinline__ void xcd_barrier(const XcdBarrier& b) {
    asm volatile("s_waitcnt vmcnt(0)" ::: "memory");
    __syncthreads();
    const int tb_ = tid_here(b.wave);
    if (tb_ == 64) asm volatile("buffer_inv sc1\n\ts_waitcnt vmcnt(0)" ::: "memory");
    if (tb_ == 0) {
        unsigned* bar = b.bar;
        __builtin_amdgcn_s_waitcnt(0);
        unsigned nloc = b.st[0], nx = b.st[1];
        if (nloc == 0u) { xcd_barrier_complete(bar, b.x, nloc, nx); b.st[0] = nloc; b.st[1] = nx; }
        const unsigned old = xb_add(&bar[XB_XSUB(b.x)], 1u);
        const unsigned gen = old / nloc;
        if (old + 1u == (gen + 1u) * nloc) {
            __builtin_amdgcn_fence(__ATOMIC_RELEASE, "agent");
            asm volatile("s_waitcnt vmcnt(0)" ::: "memory");
            const unsigned og = xb_add(&bar[XB_TOP], 1u);
            const unsigned tg = og / nx;
            if (og + 1u != (tg + 1u) * nx) XB_SPIN(xb_ld(&bar[XB_TOP]) < (tg + 1u) * nx, bar);
            (void)xb_add(&bar[XB_XGEN(b.x)], 1u);
        } else {
            XB_SPIN(xb_ld(&bar[XB_TOP]) < (gen + 1u) * nx, bar);
            asm volatile("s_waitcnt vmcnt(0)" ::: "memory");
        }
    }
    __syncthreads();
}

__device__ __forceinline__ void xcd_arrive(const XcdBarrier& b) {
    asm volatile("s_waitcnt vmcnt(0)" ::: "memory");
    __syncthreads();
    if (tid_here(b.wave) == 0) {
        unsigned* bar = b.bar;
        const unsigned nloc = b.st[0], nx = b.st[1];
        const unsigned old = xb_add(&bar[XB_XSUB(b.x)], 1u);
        const unsigned gen = old / nloc; const bool leader = old + 1u == (gen + 1u) * nloc;
        if (leader) { __builtin_amdgcn_fence(__ATOMIC_RELEASE, "agent"); asm volatile("s_waitcnt vmcnt(0)" ::: "memory"); (void)xb_add(&bar[XB_TOP], 1u); }
        b.st[4] = (gen + 1u) * nx; b.st[5] = leader ? 1u : 0u;
    }
}
__device__ __forceinline__ void xcd_wait(const XcdBarrier& b) {
    if (tid_here(b.wave) == 0) {
        unsigned* bar = b.bar; const unsigned want = b.st[4];
        XB_SPIN(xb_ld(&bar[XB_TOP]) < want, bar);
        if (b.st[5]) (void)xb_add(&bar[XB_XGEN(b.x)], 1u);
    }
    __syncthreads();
}
constexpr int CW_TEAM = 8192;
__device__ __forceinline__ void team_barrier_local(unsigned* ctl, int team, unsigned target, int wave) {
    asm volatile("s_waitcnt vmcnt(0)" ::: "memory");
    __syncthreads();
    const int tb_ = tid_here(wave);
    if (tb_ == 64) asm volatile("buffer_inv sc1\n\ts_waitcnt vmcnt(0)" ::: "memory");
    if (tb_ == 0) {
        unsigned* ctr = ctl + CW_TEAM + team * 16; unsigned* bar = ctl + CW_BAR;
        (void)xb_add(ctr, 1u);
        XB_SPIN(xb_ld(ctr) < target, bar);
    }
    __syncthreads();
}

__device__ __forceinline__ void conv_item(const float* W, int ldw, int K, int c0, int k0, const float* gain, bf16_t* Wt, int n0, LAS float* scr, int lane) {
    f32x4 v[16];
    const int kr = lane >> 4, n4 = (lane & 15) * 4;
    const float* src = W + (size_t)(k0 + kr) * ldw + c0 + n4;
#pragma unroll
    for (int i = 0; i < 16; ++i) v[i] = __builtin_nontemporal_load((const f32x4*)(src + (size_t)(4 * i) * ldw));
    if (gain) {
#pragma unroll
        for (int i = 0; i < 16; ++i) v[i] = v[i] * gain[k0 + 4 * i + kr];
    }
#pragma unroll
    for (int i = 0; i < 16; ++i) { const int k = 4 * i + kr; *(LAS f32x4*)(scr + k * 64 + (n4 ^ (((k >> 3) & 7) << 2))) = v[i]; }
    LDS_WAIT(); asm volatile("" ::: "memory");
    const int c = lane & 7;
#pragma unroll
    for (int j = 0; j < 8; ++j) { const int n = (lane >> 3) + 8 * j; const LAS float* s = scr + (8 * c) * 64 + (n ^ (c << 2));
        u32x4 o; o.x = pg8::cvt_pk_bf16(s[0 * 64], s[1 * 64]); o.y = pg8::cvt_pk_bf16(s[2 * 64], s[3 * 64]); o.z = pg8::cvt_pk_bf16(s[4 * 64], s[5 * 64]); o.w = pg8::cvt_pk_bf16(s[6 * 64], s[7 * 64]);
        *(u32x4*)(Wt + (size_t)(n0 + n) * K + k0 + 8 * c) = o; }
    LDS_WAIT(); asm volatile("" ::: "memory");
}
enum { MAP_ID = 0, MAP_GLU = 1, MAP_QKV = 2 };
__device__ __forceinline__ int map_col(int kind, int arg, int n0) {
    if (kind == MAP_GLU) { const int pn = n0 >> 8, w = n0 & 255; return (w >> 7) * 1024 + pn * 128 + (w & 127); }
    if (kind == MAP_QKV) { return ((n0 >> 10) * 3 + arg) * 1024 + (n0 & 1023); }
    return n0;
}
__device__ __forceinline__ void conv_matrix(const float* W, int ldw, int K, int N, int kind, int arg, const float* gain, bf16_t* Wt, LAS float* scr, int lane, int gw, int NGW, int& rot) {
    const int nblk = N / 64, nitems = (K / 64) * nblk;
    for (int it = (gw + NGW - rot) % NGW; it < nitems; it += NGW) { const int kb = it / nblk, nb = it % nblk; conv_item(W, ldw, K, map_col(kind, arg, nb * 64), kb * 64, gain, Wt, nb * 64, scr, lane); }
    rot = (rot + nitems) % NGW;
}
__device__ __forceinline__ float wsum_l(float v, int lane) {
#pragma unroll
    for (int o = 1; o < 64; o <<= 1) v += pg8::shx(v, lane, o);
    return v;
}
__device__ __forceinline__ float row_f32_to_bf16(const float* xrow, bf16_t* oraw, bf16_t* onorm, int lane) {
    const f32x4* xr = (const f32x4*)xrow + lane;
    f32x4 v[4]; float s = 0.f;
#pragma unroll
    for (int j = 0; j < 4; ++j) { v[j] = xr[64 * j]; s += (v[j].x * v[j].x + v[j].y * v[j].y) + (v[j].z * v[j].z + v[j].w * v[j].w); }
    const float rstd = rsqrtf(wsum_l(s, lane) * (1.0f / DM) + EPS);
    if (oraw) { u32x2* o = (u32x2*)oraw + lane;
#pragma unroll
        for (int j = 0; j < 4; ++j) { u32x2 w; w.x = pk2(v[j].x, v[j].y); w.y = pk2(v[j].z, v[j].w); o[64 * j] = w; } }
    if (onorm) { u32x2* o = (u32x2*)onorm + lane;
#pragma unroll
        for (int j = 0; j < 4; ++j) { u32x2 w; w.x = pk2(v[j].x * rstd, v[j].y * rstd); w.y = pk2(v[j].z * rstd, v[j].w * rstd); o[64 * j] = w; } }
    return rstd;
}
template <bool F32SRC> __device__ __forceinline__ void unorm_chunk(LAS unsigned char* lds, const float* xsrc, bf16_t* hbio, bf16_t* Ug, int chunk, const int tid) {
    const int lane = tid & 63, wid = __builtin_amdgcn_readfirstlane(tid >> 6);
    LAS unsigned char* T = lds;
#pragma unroll
    for (int rr = 0; rr < 2; ++rr) { const int s = 2 * wid + rr; const size_t row = (size_t)chunk * 16 + s;
        if (F32SRC) { const f32x4* xr = (const f32x4*)(xsrc + row * DM) + lane; f32x4 v[4]; float ss = 0.f;
#pragma unroll
            for (int j = 0; j < 4; ++j) { v[j] = __builtin_nontemporal_load(xr + 64 * j); ss += (v[j].x * v[j].x + v[j].y * v[j].y) + (v[j].z * v[j].z + v[j].w * v[j].w); }
            const float rstd = rsqrtf(wsum_l(ss, lane) * (1.0f / DM) + EPS);
            u32x2* o = (u32x2*)(hbio + row * DM) + lane;
#pragma unroll
            for (int j = 0; j < 4; ++j) { u32x2 w; w.x = pg8::cvt_pk_bf16(v[j].x, v[j].y); w.y = pg8::cvt_pk_bf16(v[j].z, v[j].w); o[64 * j] = w;
                u32x2 q; q.x = pg8::cvt_pk_bf16(v[j].x * rstd, v[j].y * rstd); q.y = pg8::cvt_pk_bf16(v[j].z * rstd, v[j].w * rstd); *(LAS u32x2*)(T + s * 2080 + (64 * j + lane) * 8) = q; }
        } else { const u32x4* xr = (const u32x4*)(hbio + row * DM) + lane; u32x4 w[2]; float v[16]; float ss = 0.f;
#pragma unroll
            for (int j = 0; j < 2; ++j) { w[j] = xr[64 * j];
                v[8 * j + 0] = __uint_as_float(w[j].x << 16); v[8 * j + 1] = __uint_as_float(w[j].x & 0xffff0000u); v[8 * j + 2] = __uint_as_float(w[j].y << 16); v[8 * j + 3] = __uint_as_float(w[j].y & 0xffff0000u);
                v[8 * j + 4] = __uint_as_float(w[j].z << 16); v[8 * j + 5] = __uint_as_float(w[j].z & 0xffff0000u); v[8 * j + 6] = __uint_as_float(w[j].w << 16); v[8 * j + 7] = __uint_as_float(w[j].w & 0xffff0000u); }
#pragma unroll
            for (int i = 0; i < 16; ++i) ss += v[i] * v[i];
            const float rstd = rsqrtf(wsum_l(ss, lane) * (1.0f / DM) + EPS);
#pragma unroll
            for (int j = 0; j < 2; ++j) { u32x4 q; q.x = pg8::cvt_pk_bf16(v[8 * j] * rstd, v[8 * j + 1] * rstd); q.y = pg8::cvt_pk_bf16(v[8 * j + 2] * rstd, v[8 * j + 3] * rstd);
                q.z = pg8::cvt_pk_bf16(v[8 * j + 4] * rstd, v[8 * j + 5] * rstd); q.w = pg8::cvt_pk_bf16(v[8 * j + 6] * rstd, v[8 * j + 7] * rstd); *(LAS u32x4*)(T + s * 2080 + (64 * j + lane) * 16) = q; } }
    }
    LDS_WAIT(); __syncthreads();
#pragma unroll
    for (int i = 0; i < 4; ++i) { const int gq = 8 * wid + 2 * i + (lane >> 5), l = lane & 31, s = l >> 1, hf = l & 1;
        const u32x4 q = *(const LAS u32x4*)(T + s * 2080 + gq * 32 + hf * 16);
        *(u32x4*)(Ug + ((size_t)gq * 1024 + chunk) * 256 + l * 8) = q; }
    LDS_WAIT(); __syncthreads();
}

struct S5In { const float *lam_re, *lam_im, *log_dt, *b_re, *b_im, *c_re, *c_im, *dskip, *gain; };
typedef float f32x2v __attribute__((ext_vector_type(2)));
__device__ __forceinline__ void s5_gen(LAS unsigned char* lds, const S5In P, int g, int q, bf16_t* Bst, bf16_t* Bout, const int tid) {
    LAS f32x2v* pw = (LAS f32x2v*)lds;
    LAS f32x2v* bb = (LAS f32x2v*)(lds + 17408);
    LAS f32x2v* cc = (LAS f32x2v*)(lds + 33792);
    LAS float* kt = (LAS float*)(lds + 50176);
    if (tid < 128) {
        const int di = tid >> 6, p = tid & 63, gp = (di * 64 + g) * 64 + p;
        const float dt = __builtin_amdgcn_exp2f(P.log_dt[di * 64 + g] * 1.4426950408889634f);
        const float lr = P.lam_re[gp], li = P.lam_im[gp];
        const float mag = __builtin_amdgcn_exp2f(lr * dt * 1.4426950408889634f), frv = __builtin_amdgcn_fractf(li * dt * 0.15915494309189535f);
        const float ar = mag * __builtin_amdgcn_cosf(frv), ai = mag * __builtin_amdgcn_sinf(frv);
        const float nr = ar - 1.0f, ni = ai, den = lr * lr + li * li;
        const float fr = (nr * lr + ni * li) / den, fi = (ni * lr - nr * li) / den;
        float wr = 1.0f, wi = 0.0f;
        for (int k = 0; k <= 16; ++k) { pw[(di * 64 + p) * 17 + k] = (f32x2v){wr, wi}; const float t = wr * ar - wi * ai; wi = wr * ai + wi * ar; wr = t; }
        for (int c = 0; c < 16; ++c) { const float br = P.b_re[(size_t)gp * 16 + c], bi = P.b_im[(size_t)gp * 16 + c];
            bb[(di * 64 + p) * 16 + c] = (f32x2v){fr * br - fi * bi, fr * bi + fi * br}; }
    }
    for (int e = tid; e < 2048; e += 512) { const int di = e >> 10, c = (e >> 6) & 15, p = e & 63; const size_t o = ((size_t)(di * 64 + g) * 16 + c) * 64 + p; cc[e] = (f32x2v){P.c_re[o], P.c_im[o]}; }
    __syncthreads();
    { const int di = tid >> 8, k = (tid >> 4) & 15, chb = (tid >> 2) & 3, c2b = tid & 3;
      float acc[4][4];
#pragma unroll
      for (int a_ = 0; a_ < 4; ++a_)
#pragma unroll
          for (int b_ = 0; b_ < 4; ++b_) acc[a_][b_] = 0.f;
      for (int p = 0; p < 64; ++p) { const f32x2v w = pw[(di * 64 + p) * 17 + k]; float zr[4], zi[4];
#pragma unroll
          for (int b_ = 0; b_ < 4; ++b_) { const f32x2v b = bb[(di * 64 + p) * 16 + 4 * c2b + b_]; zr[b_] = w.x * b.x - w.y * b.y; zi[b_] = w.x * b.y + w.y * b.x; }
#pragma unroll
          for (int a_ = 0; a_ < 4; ++a_) { const f32x2v C = cc[(di * 16 + 4 * chb + a_) * 64 + p];
#pragma unroll
              for (int b_ = 0; b_ < 4; ++b_) acc[a_][b_] += C.x * zr[b_] - C.y * zi[b_]; } }
#pragma unroll
      for (int a_ = 0; a_ < 4; ++a_)
#pragma unroll
          for (int b_ = 0; b_ < 4; ++b_) kt[((di * 16 + k) * 16 + 4 * chb + a_) * 16 + 4 * c2b + b_] = acc[a_][b_]; }
    __syncthreads();
    { const int di = q >> 1, ri = q & 1;
      for (int cid = tid; cid < 2048; cid += 512) { const int nl = cid >> 5, k0 = (cid & 31) * 8, r = k0 >> 4, ch0 = k0 & 15;
        const f32x2v w = pw[(di * 64 + nl) * 17 + (di == 0 ? 15 - r : r)]; float v[8];
#pragma unroll
        for (int j = 0; j < 8; ++j) { const f32x2v b = bb[(di * 64 + nl) * 16 + ch0 + j]; const float zr = w.x * b.x - w.y * b.y, zi = w.x * b.y + w.y * b.x; v[j] = (ri == 0 ? zr : zi) * P.gain[g * 16 + ch0 + j]; }
        u32x4 o; o.x = pk2(v[0], v[1]); o.y = pk2(v[2], v[3]); o.z = pk2(v[4], v[5]); o.w = pk2(v[6], v[7]);
        *(u32x4*)(Bst + ((size_t)g * 256 + q * 64 + nl) * 256 + k0) = o; } }
    for (int cid = tid; cid < 4096; cid += 512) { const int nl = cid >> 6, k0 = (cid & 63) * 8, n = q * 64 + nl, s = n >> 4, ch = n & 15; float v[8];
        if (k0 < 256) { const int r = k0 >> 4, c0 = k0 & 15;
#pragma unroll
            for (int j = 0; j < 8; ++j) { const int c2 = c0 + j; float t = 0.f;
                if (r <= s) t += kt[((0 * 16 + (s - r)) * 16 + ch) * 16 + c2];
                if (r >= s) t += kt[((1 * 16 + (r - s)) * 16 + ch) * 16 + c2];
                if (r == s && c2 == ch) t += P.dskip[g * 16 + ch];
                v[j] = t * P.gain[g * 16 + c2]; }
        } else { const int kk = k0 - 256, di = kk >> 7, ri = (kk >> 6) & 1, p0 = kk & 63;
#pragma unroll
            for (int j = 0; j < 8; ++j) { const int p = p0 + j; const f32x2v C = cc[(di * 16 + ch) * 64 + p], w = pw[(di * 64 + p) * 17 + (di == 0 ? s + 1 : 16 - s)];
                v[j] = ri == 0 ? (C.x * w.x - C.y * w.y) : -(C.x * w.y + C.y * w.x); } }
        u32x4 o; o.x = pk2(v[0], v[1]); o.y = pk2(v[2], v[3]); o.z = pk2(v[4], v[5]); o.w = pk2(v[6], v[7]);
        *(u32x4*)(Bout + ((size_t)g * 256 + n) * 512 + k0) = o; }
    __syncthreads();
}

__device__ __forceinline__ void s5_scan_bg(LAS unsigned char* lds, const S5In P, const bf16_t* F, bf16_t* XB, int b, int g, const int tid) {
    const int lane = tid & 63, wid = __builtin_amdgcn_readfirstlane(tid >> 6), p = lane;
    LAS f32x2v* E = (LAS f32x2v*)lds;
    LAS f32x2v* XI = (LAS f32x2v*)(lds + 16384);
    float a1r[2], a1i[2], a16r[2], a16i[2];
#pragma unroll
    for (int di = 0; di < 2; ++di) { const int gp = (di * 64 + g) * 64 + p;
        const float dt = expf(P.log_dt[di * 64 + g]); const float lr = P.lam_re[gp], li = P.lam_im[gp];
        const float mag = expf(lr * dt), ang = li * dt; float ar = mag * cosf(ang), ai = mag * sinf(ang);
#pragma unroll
        for (int sq = 0; sq < 4; ++sq) { const float t = ar * ar - ai * ai; ai = 2.f * ar * ai; ar = t; }
        a1r[di] = ar; a1i[di] = ai;
#pragma unroll
        for (int sq = 0; sq < 4; ++sq) { const float t = ar * ar - ai * ai; ai = 2.f * ar * ai; ar = t; }
        a16r[di] = ar; a16i[di] = ai; }
    const bf16_t* Fb = F + ((size_t)g * 1024 + b * 256) * 256;
    float fr[4][16], fi[4][16];
#pragma unroll
    for (int jj = 0; jj < 4; ++jj) { const int job = wid + 8 * jj, di = job >> 4, seg = job & 15;
#pragma unroll
        for (int j = 0; j < 16; ++j) { const int c = di == 0 ? seg * 16 + j : 255 - (seg * 16 + j); const bf16_t* fp = Fb + (size_t)c * 256 + di * 128 + p; fr[jj][j] = bf2f(fp[0]); fi[jj][j] = bf2f(fp[64]); } }
#pragma unroll
    for (int jj = 0; jj < 4; ++jj) { const int job = wid + 8 * jj, di = job >> 4, seg = job & 15;
        const float ar = di ? a1r[1] : a1r[0], ai = di ? a1i[1] : a1i[0]; float xr = 0.f, xi = 0.f;
#pragma unroll
        for (int j = 0; j < 16; ++j) { const float nxr = ar * xr - ai * xi + fr[jj][j], nxi = ar * xi + ai * xr + fi[jj][j]; xr = nxr; xi = nxi; }
        E[(di * 16 + seg) * 64 + p] = (f32x2v){xr, xi}; }
    LDS_WAIT(); __syncthreads();
    if (tid < 128) { const int di = tid >> 6; const float ar = di ? a16r[1] : a16r[0], ai = di ? a16i[1] : a16i[0]; float xr = 0.f, xi = 0.f;
        for (int seg = 0; seg < 16; ++seg) { XI[(di * 16 + seg) * 64 + p] = (f32x2v){xr, xi}; const f32x2v e = E[(di * 16 + seg) * 64 + p];
            const float nxr = ar * xr - ai * xi + e.x, nxi = ar * xi + ai * xr + e.y; xr = nxr; xi = nxi; } }
    LDS_WAIT(); __syncthreads();
#pragma unroll
    for (int jj = 0; jj < 4; ++jj) { const int job = wid + 8 * jj, di = job >> 4, seg = job & 15;
        const float ar = di ? a1r[1] : a1r[0], ai = di ? a1i[1] : a1i[0]; const f32x2v x0 = XI[(di * 16 + seg) * 64 + p]; float xr = x0.x, xi = x0.y;
        bf16_t* xg = XB + ((size_t)g * 1024 + b * 256) * 256 + di * 128 + p;
#pragma unroll
        for (int j = 0; j < 16; ++j) { const int c = di == 0 ? seg * 16 + j : 255 - (seg * 16 + j);
            xg[(size_t)c * 256] = (bf16_t)f2bf(xr); xg[(size_t)c * 256 + 64] = (bf16_t)f2bf(xi);
            const float nxr = ar * xr - ai * xi + fr[jj][j], nxi = ar * xi + ai * xr + fi[jj][j]; xr = nxr; xi = nxi; } }
    __syncthreads();
}
namespace att {
typedef float f32x16 __attribute__((ext_vector_type(16)));
typedef short bf16x8 __attribute__((ext_vector_type(8)));
typedef short v4i16_t __attribute__((ext_vector_type(4)));
typedef LAS const char* lds_cptr;
__device__ __forceinline__ v4i16_t vtr(lds_cptr p) { return __builtin_amdgcn_ds_read_tr16_b64_v4i16((LAS v4i16_t*)p); }
__device__ __forceinline__ void glds16(const void* gsrc, LAS unsigned char* dst_uniform) { __builtin_amdgcn_global_load_lds((const unsigned*)gsrc, (LAS unsigned*)dst_uniform, 16, 0, 0); }
__device__ __forceinline__ unsigned pkbf(float lo, float hi) { return pg8::cvt_pk_bf16(lo, hi); }
__device__ __forceinline__ bf16x8 pack8(const f32x16& p, int base) {
    u32x4 w; w.x = pkbf(p[base + 0], p[base + 1]); w.y = pkbf(p[base + 2], p[base + 3]); w.z = pkbf(p[base + 4], p[base + 5]); w.w = pkbf(p[base + 6], p[base + 7]);
    return __builtin_bit_cast(bf16x8, w);
}
#define ATT_SYNC() do { asm volatile("s_waitcnt vmcnt(0) lgkmcnt(0)" ::: "memory"); __syncthreads(); } while (0)

template <bool MERGE> __device__ __forceinline__ void store_ot(const f32x16& acc, float sc, bf16_t* rowp  , int hi, float wa, float wb, const u32x4 (&oldv)[2]) {
    unsigned w[8];
#pragma unroll
    for (int g = 0; g < 4; ++g) { w[2 * g] = pkbf(acc[4 * g] * sc, acc[4 * g + 1] * sc); w[2 * g + 1] = pkbf(acc[4 * g + 2] * sc, acc[4 * g + 3] * sc); }
#pragma unroll
    for (int g = 0; g < 4; g += 2) {
        const auto rx = __builtin_amdgcn_permlane32_swap(w[2 * g], w[2 * g + 2], false, false);
        const auto ry = __builtin_amdgcn_permlane32_swap(w[2 * g + 1], w[2 * g + 3], false, false);
        u32x4 o; o.x = rx[0]; o.y = ry[0]; o.z = rx[1]; o.w = ry[1];
        u32x4* dst = (u32x4*)(rowp + 8 * g + (hi ? 8 : 0));
        if (MERGE) { const u32x4 old = oldv[g >> 1];
#define ATT_MRG(N, O) pkbf(__uint_as_float((O) << 16) * wa + __uint_as_float((N) << 16) * wb, __uint_as_float((O) & 0xffff0000u) * wa + __uint_as_float((N) & 0xffff0000u) * wb)
            o.x = ATT_MRG(o.x, old.x); o.y = ATT_MRG(o.y, old.y); o.z = ATT_MRG(o.z, old.z); o.w = ATT_MRG(o.w, old.w);
#undef ATT_MRG
        }
        *dst = o;
    }
}

__device__ __forceinline__ void xattn_unit(LAS unsigned char* lds, const bf16_t* Qx, const bf16_t* KV, int li, int b, int h, int qb, bf16_t* XO, const int tid) {
    const int lane = tid & 63, wid = __builtin_amdgcn_readfirstlane(tid >> 6), r32 = lane & 31, hi = lane >> 5;
    const size_t tok = (size_t)b * SEQ + qb * 256 + wid * 32 + r32;
    const bf16_t* Kb = KV + (size_t)b * MEMLEN * 8192 + li * 2048 + h * 256;
#pragma unroll 4
    for (int ii = 0; ii < 16; ++ii) { const int i = wid * 16 + ii, key = 2 * i + hi, c = r32 ^ (key & 15);
        glds16(Kb + (size_t)key * 8192 + c * 8, lds + i * 1024); }
    bf16x8 qf[16]; { const bf16_t* qp = Qx + tok * 1024 + h * 256 + hi * 8;
#pragma unroll
        for (int s = 0; s < 16; ++s) qf[s] = *(const bf16x8*)(qp + 16 * s); }
    ATT_SYNC();
    f32x16 S[8];
#pragma unroll
    for (int kt = 0; kt < 8; ++kt) { f32x16 acc = {}; const lds_cptr kp = (lds_cptr)lds + (32 * kt + r32) * 512;
#pragma unroll
        for (int s = 0; s < 16; ++s) { const bf16x8 kf = *(const LAS bf16x8*)(kp + (((2 * s + hi) ^ (r32 & 15)) << 4)); acc = __builtin_amdgcn_mfma_f32_32x32x16_bf16(kf, qf[s], acc, 0, 0, 0); }
        S[kt] = acc; }
    float m = S[0][0];
#pragma unroll
    for (int kt = 0; kt < 8; ++kt)
#pragma unroll
        for (int r = 0; r < 16; ++r) m = fmaxf(m, S[kt][r]);
    m = fmaxf(m, pg8::shx(m, lane, 32));
    float l = 0.f;
#pragma unroll
    for (int kt = 0; kt < 8; ++kt)
#pragma unroll
        for (int r = 0; r < 16; ++r) { const float p = __builtin_amdgcn_exp2f(S[kt][r] - m); S[kt][r] = p; l += p; }
    l += pg8::shx(l, lane, 32);
    const float inv = __builtin_amdgcn_rcpf(l);
    bf16x8 pf[16];
#pragma unroll
    for (int kt = 0; kt < 8; ++kt) { pf[2 * kt] = pack8(S[kt], 0); pf[2 * kt + 1] = pack8(S[kt], 8); }
    ATT_SYNC();
    const bf16_t* Vb = Kb + 1024;
#pragma unroll 4
    for (int ii = 0; ii < 16; ++ii) { const int i = wid * 16 + ii, d0 = i >> 4, ks = i & 15, key = 16 * ks + 8 * hi + ((lane >> 2) & 7), cc = lane & 3;
        glds16(Vb + (size_t)key * 8192 + 32 * d0 + 8 * cc, lds + i * 1024); }
    ATT_SYNC();
    const lds_cptr vb = (lds_cptr)lds + ((lane >> 4) & 1) * 32 + (lane & 3) * 8 + (4 * hi + ((lane & 15) >> 2)) * 64;
    bf16_t* orow = XO + tok * 1024 + h * 256;
#pragma unroll 1
    for (int d0 = 0; d0 < 8; ++d0) { f32x16 acc = {};
#pragma unroll
        for (int ks = 0; ks < 16; ++ks) { const v4i16_t lo = vtr(vb + d0 * 16384 + ks * 1024), hh = vtr(vb + d0 * 16384 + ks * 1024 + 512);
            const bf16x8 vf = {lo[0], lo[1], lo[2], lo[3], hh[0], hh[1], hh[2], hh[3]};
            acc = __builtin_amdgcn_mfma_f32_32x32x16_bf16(vf, pf[ks], acc, 0, 0, 0); }
        const u32x4 none[2] = {}; store_ot<false>(acc, inv, orow + 32 * d0, hi, 0.f, 0.f, none); }
    ATT_SYNC();
}

__device__ __forceinline__ void dil_unit(LAS unsigned char* lds, const LAS float* btab, const bf16_t* QKV, int gi, int ldil, int b, int h, int r, int ub, bf16_t* AO, float* lseacc, const int tid) {
    const int lane = tid & 63, wid = __builtin_amdgcn_readfirstlane(tid >> 6), r32 = lane & 31, hi = lane >> 5;
    const int sub_len = SEQ >> ldil, k0 = ub * 256 - 64;
    const size_t tokb = (size_t)b * SEQ + r;
    const bf16_t* base = QKV + h * 128;
#pragma unroll 4
    for (int ii = 0; ii < 12; ++ii) { const int i = wid * 12 + ii, kk = 4 * i + (lane >> 4), c = (lane & 15) ^ (kk & 15); int ki = k0 + kk; ki = ki < 0 ? 0 : (ki >= sub_len ? sub_len - 1 : ki);
        glds16(base + (tokb + ((size_t)ki << ldil)) * 3072 + 1024 + c * 8, lds + i * 1024); }
    const int qi = ub * 256 + wid * 32 + r32; const size_t qtok = tokb + ((size_t)qi << ldil);
    bf16x8 qf[8]; { const bf16_t* qp = base + qtok * 3072 + hi * 8;
#pragma unroll
        for (int s = 0; s < 8; ++s) qf[s] = *(const bf16x8*)(qp + 16 * s); }
    ATT_SYNC();
    f32x16 S[5];
    int r15 = r32 & 15; asm volatile("" : "+v"(r15));
#pragma unroll
    for (int t = 0; t < 5; ++t) { f32x16 acc = {}; const lds_cptr kp = (lds_cptr)lds + (32 * wid + 32 * t + r32) * 256;
#pragma unroll
        for (int s = 0; s < 8; ++s) { const bf16x8 kf = *(const LAS bf16x8*)(kp + (((2 * s + hi) ^ r15) << 4)); acc = __builtin_amdgcn_mfma_f32_32x32x16_bf16(kf, qf[s], acc, 0, 0, 0); }
        S[t] = acc; }
    ATT_SYNC();
#pragma unroll 1
    for (int ii = 0; ii < 12; ++ii) { const int i = wid * 12 + ii, d0 = i / 24, ks = i % 24, kk = 16 * ks + 8 * hi + ((lane >> 2) & 7), cc = lane & 3; int ki = k0 + kk; ki = ki < 0 ? 0 : (ki >= sub_len ? sub_len - 1 : ki);
        glds16(base + (tokb + ((size_t)ki << ldil)) * 3072 + 2048 + 32 * d0 + 8 * cc, lds + i * 1024); }
    float m = -3.0e38f;
#pragma unroll
    for (int t = 0; t < 5; ++t)
#pragma unroll
        for (int rr = 0; rr < 16; ++rr) { const int cr = (rr & 3) + 8 * (rr >> 2) + 4 * hi, jk = 32 * t + cr - r32, ki = k0 + 32 * wid + 32 * t + cr;
            float s = S[t][rr] + btab[jk + 32];
            s = ((unsigned)ki < (unsigned)sub_len) ? s : -1e30f;
            S[t][rr] = s; m = fmaxf(m, s); }
    m = fmaxf(m, pg8::shx(m, lane, 32));
    float l = 0.f;
#pragma unroll
    for (int t = 0; t < 5; ++t)
#pragma unroll
        for (int rr = 0; rr < 16; ++rr) { const float p = __builtin_amdgcn_exp2f(S[t][rr] - m); S[t][rr] = p; l += p; }
    l += pg8::shx(l, lane, 32);
    const float inv = __builtin_amdgcn_rcpf(l), lse = m + __builtin_amdgcn_logf(l);
    bf16x8 pf[10];
#pragma unroll
    for (int t = 0; t < 5; ++t) { pf[2 * t] = pack8(S[t], 0); pf[2 * t + 1] = pack8(S[t], 8); }
    bf16_t* orow = AO + qtok * 1024 + h * 128;
    u32x4 oldv[4][2] = {};
    if (gi > 0) {
#pragma unroll
        for (int d0 = 0; d0 < 4; ++d0)
#pragma unroll
            for (int g2 = 0; g2 < 2; ++g2) oldv[d0][g2] = *(const u32x4*)(orow + 32 * d0 + 16 * g2 + (hi ? 8 : 0)); }
    float wa = 0.f, wb = 1.f, ln = lse;
    float* lp = lseacc + qtok * 8 + h;
    if (gi > 0) { const float la = *lp, mx = fmaxf(la, lse); ln = mx + __builtin_amdgcn_logf(__builtin_amdgcn_exp2f(la - mx) + __builtin_amdgcn_exp2f(lse - mx)); wa = __builtin_amdgcn_exp2f(la - ln); wb = __builtin_amdgcn_exp2f(lse - ln); }
    ATT_SYNC();
    const lds_cptr vb = (lds_cptr)lds + ((lane >> 4) & 1) * 32 + (lane & 3) * 8 + (4 * hi + ((lane & 15) >> 2)) * 64 + 2 * wid * 1024;
#pragma unroll
    for (int d0 = 0; d0 < 4; ++d0) { f32x16 acc = {};
#pragma unroll
        for (int k = 0; k < 10; ++k) { const v4i16_t lo = vtr(vb + (d0 * 24 + k) * 1024), hh = vtr(vb + (d0 * 24 + k) * 1024 + 512);
            const bf16x8 vf = {lo[0], lo[1], lo[2], lo[3], hh[0], hh[1], hh[2], hh[3]};
            acc = __builtin_amdgcn_mfma_f32_32x32x16_bf16(vf, pf[k], acc, 0, 0, 0); }
        if (gi > 0) store_ot<true>(acc, inv, orow + 32 * d0, hi, wa, wb, oldv[d0]); else store_ot<false>(acc, inv, orow + 32 * d0, hi, 0.f, 0.f, oldv[d0]); }
    if (hi == 0) *lp = ln;
    ATT_SYNC();
}
#undef ATT_SYNC
}
struct Args { const float* in[27]; float* out; unsigned char* ws; int ph_lo, ph_hi; };
static_assert(sizeof(Args) == 27 * 8 + 8 + 8 + 8, "Args must have no padding");
enum { K_NONE = 0, K_PREP, K_S5STATE, K_SCAN, K_S5OUT, K_GLU, K_KV, K_QKV, K_DIL, K_RES, K_XQ, K_XATTN, K_MLP1 };
__host__ __device__ __forceinline__ int phase_kind(int li, int sub) {
    const bool odd = li & 1;
    switch (sub) {
        case 0: return K_PREP;
        case 1: return odd ? K_QKV : K_S5STATE;
        case 2: return odd ? K_DIL : K_NONE;
        case 3: return odd ? K_QKV : K_NONE;
        case 4: return odd ? K_DIL : K_GLU;
        case 5: return odd ? K_QKV : K_NONE;
        case 6: return odd ? K_DIL : K_NONE;
        case 7: return odd ? K_RES : K_NONE;
        case 8: return K_XQ;
        case 9: return K_NONE;
        case 10: return K_RES;
        case 11: return K_MLP1;
        case 12: return K_RES;
        default: return K_NONE;
    }
}

__global__ void __launch_bounds__(NWAVES * 64, 2) mk_fwd(Args a) {
    extern __shared__ __attribute__((aligned(16))) unsigned char lds_raw[];
    LAS unsigned char* lds = (LAS unsigned char*)lds_raw;
    const int tid0 = threadIdx.x, wave0 = __builtin_amdgcn_readfirstlane(tid0 >> 6);
    const int G = gridDim.x, bx = blockIdx.x, vcu = (G % 8 == 0) ? (bx % 8) * (G / 8) + bx / 8 : bx, NGW = G * NWAVES;
    volatile LAS unsigned* MISC = (volatile LAS unsigned*)(lds + MISC_OFF);
    for (int u = tid0; u < 64; u += NWAVES * 64) MISC[u] = 0u;
    __syncthreads();
    volatile LAS unsigned long long* LP = (volatile LAS unsigned long long*)(lds + MISC_OFF + 256);
    if (tid0 == 0) {
#pragma unroll
        for (int i = 0; i < 27; ++i) LP[i] = (unsigned long long)a.in[i];
        LP[27] = (unsigned long long)a.out; LP[28] = (unsigned long long)a.ws;
    }
    __syncthreads();
#define LDP(i) ((unsigned char*)(GAS unsigned char*)(((unsigned long long)(unsigned)__builtin_amdgcn_readfirstlane((int)(LPv[i] >> 32)) << 32) | (unsigned long long)(unsigned)__builtin_amdgcn_readfirstlane((int)(unsigned)LPv[i])))
#define INP(i) ((const float*)LDP(i))
    XcdBarrier bar = xcd_barrier_post((unsigned*)(a.ws + WS_CTL) + CW_BAR, MISC + 8);
#define out ((float*)LDP(27))
#define ssq ((float*)(wsb + WS_SSQ))
#define rstd_mem ((float*)(wsb + WS_MISC))
#define biasrel ((float*)(wsb + WS_MISC + 16384))
#define hb ((bf16_t*)(wsb + WS_HB))
#define kvall ((bf16_t*)(wsb + WS_KV))
#define memb ((bf16_t*)(wsb + WS_MEMB))
#define T1 ((bf16_t*)(wsb + WS_T1))
#define T2 ((bf16_t*)(wsb + WS_T2))
#define BIG (wsb + WS_BIG)
#define WR (wsb + WS_W)

#ifndef STAG_TICKS
#define STAG_TICKS 0
#endif
#define STAGGER() do { if (STAG_TICKS) { const unsigned long long t0_ = __builtin_amdgcn_s_memrealtime(); const unsigned long long dl_ = (unsigned long long)(vcu >> 6) * STAG_TICKS; while (__builtin_amdgcn_s_memrealtime() - t0_ < dl_) __builtin_amdgcn_s_sleep(1); } } while (0)
    bool first = true;
#ifndef SPLIT_WAR_SEAMS
#define SPLIT_WAR_SEAMS 1
#endif
#ifndef TEAM_LOCAL_SEAMS
#define TEAM_LOCAL_SEAMS 1
#endif
#ifdef DUP_KIND
    bool dupdone = false;
#else
    const bool dupdone = false;
#endif
    for (int ph = a.ph_lo; ph < a.ph_hi; ++ph) {
        const int li = ph >> 4, sub = ph & 15, j = li >> 1, kind = phase_kind(li, sub);
        if (kind == K_NONE) continue;
        unsigned lpo = MISC_OFF + 256; asm volatile("" : "+v"(lpo));
        volatile LAS unsigned long long* LPv = (volatile LAS unsigned long long*)(lds + lpo);
#ifndef REP_GRID
#define REP_GRID 1
#endif
        const bool teamseam = TEAM_LOCAL_SEAMS && G == 256 && !dupdone && (sub == 8 || sub == 10 || sub == 11 || sub == 12) && MISC[8 + 2] != 0u;
        const bool warseam = SPLIT_WAR_SEAMS && G == 256 && !dupdone && kind == K_QKV && sub != 1;
#ifndef SPLIT_PREP_SEAMS
#define SPLIT_PREP_SEAMS 1
#endif
        const bool prepseam = SPLIT_PREP_SEAMS && G == 256 && !dupdone && kind == K_PREP && li > 0;
        const bool qkv0seam = SPLIT_PREP_SEAMS && G == 256 && !dupdone && kind == K_QKV && sub == 1 && li > 0;
        if (!first && qkv0seam) { XcdBarrier b2 = bar; b2.bar = (unsigned*)(LDP(28) + WS_CTL) + CW_BAR; xcd_wait(b2);
            if (tid_here(wave0) == 64) asm volatile("buffer_inv sc1\n\ts_waitcnt vmcnt(0)" ::: "memory");
            __syncthreads(); }
        else if (!first && (warseam || prepseam)) { XcdBarrier b2 = bar; b2.bar = (unsigned*)(LDP(28) + WS_CTL) + CW_BAR; xcd_arrive(b2); }
        else if (!first && teamseam) { const unsigned tbk = 4u * (unsigned)li + (sub == 8 ? 1u : (sub == 10 ? 2u : (sub == 11 ? 3u : 4u)));
            team_barrier_local((unsigned*)(LDP(28) + WS_CTL), 8 * (bx & 7) + ((bx >> 3) & 7), 4u * tbk, wave0); }
        else if (!first) { for (int rp = 0; rp < REP_GRID; ++rp) { XcdBarrier b2 = bar; b2.bar = (unsigned*)(LDP(28) + WS_CTL) + CW_BAR; xcd_barrier(b2); }
            if (G == 256 && li == 0 && sub == 1 && tid_here(wave0) == 0) { unsigned* bw = (unsigned*)(LDP(28) + WS_CTL) + CW_BAR; const unsigned me = xb_ld(&bw[XB_XCCID + bx]); bool loc = true;
                for (int q = 0; q < 4; ++q) loc = loc && (xb_ld(&bw[XB_XCCID + (bx & 63) + 64 * q]) == me);
                if (loc) (void)xb_add(&bw[XB_NLOCAL], 1u); }
            if (G == 256 && li == 0 && sub == 4) { if (tid_here(wave0) == 0) { unsigned* bw = (unsigned*)(LDP(28) + WS_CTL) + CW_BAR; MISC[8 + 2] = (xb_ld(&bw[XB_NLOCAL]) == (unsigned)G) ? 1u : 0u; } __syncthreads(); }
        }
        first = false;
        unsigned char* const wsb = LDP(28);
#define PHASE_TID int zero_ = 0; asm volatile("" : "+v"(zero_)); const int tid = wave0 * 64 + (int)__builtin_amdgcn_mbcnt_hi(~0u, __builtin_amdgcn_mbcnt_lo(~0u, (unsigned)zero_)); \
        const int lane = tid & 63, wave = wave0, gw = vcu * NWAVES + wave0; (void)lane; (void)wave; (void)gw
#define SP_INIT const S5In sp{INP(7) + (size_t)j * 8192, INP(8) + (size_t)j * 8192, INP(9) + (size_t)j * 128, INP(10) + (size_t)j * 131072, INP(11) + (size_t)j * 131072, \
                      INP(12) + (size_t)j * 131072, INP(13) + (size_t)j * 131072, INP(14) + (size_t)j * DM, INP(3) + (size_t)li * DM}
        if (kind == K_PREP) { PHASE_TID;
            LAS float* scr = (LAS float*)(lds + wave * 16384);
            int rot = 0;
            if (!(li & 1)) { SP_INIT; for (int it = bx; it < 256; it += G) s5_gen(lds, sp, it >> 2, it & 3, (bf16_t*)(WR + W_BST), (bf16_t*)(WR + W_BOUT), tid);
                conv_matrix(INP(15) + (size_t)j * DM * 2048, 2048, DM, 2048, MAP_GLU, 0, nullptr, (bf16_t*)(WR + W_GLU), scr, lane, gw, NGW, rot);
            } else {
                conv_matrix(INP(17) + (size_t)j * DM * DM, DM, DM, DM, MAP_ID, 0, nullptr, (bf16_t*)(WR + W_AO), scr, lane, gw, NGW, rot);
                for (int gi = 2; gi >= 0; --gi)
                    conv_matrix(INP(16) + (size_t)j * DM * 9216, 9216, DM, 3072, MAP_QKV, gi, INP(3) + (size_t)li * DM, (bf16_t*)(WR + W_QKV) + (size_t)gi * 3072 * DM, scr, lane, gw, NGW, rot);
            }
            if (prepseam) { XcdBarrier b2 = bar; b2.bar = (unsigned*)(LDP(28) + WS_CTL) + CW_BAR; xcd_wait(b2);
                if (tid == 64) asm volatile("buffer_inv sc1\n\ts_waitcnt vmcnt(0)" ::: "memory");
                __syncthreads();
                if (li & 1) { XcdBarrier b3 = bar; b3.bar = (unsigned*)(LDP(28) + WS_CTL) + CW_BAR; xcd_arrive(b3); } }
            conv_matrix(INP(20) + (size_t)li * DM * DM, DM, DM, DM, MAP_ID, 0, INP(4) + (size_t)li * DM, (bf16_t*)(WR + W_XQ), scr, lane, gw, NGW, rot);
            conv_matrix(INP(22) + (size_t)li * DM * DM, DM, DM, DM, MAP_ID, 0, nullptr, (bf16_t*)(WR + W_XO), scr, lane, gw, NGW, rot);
            conv_matrix(INP(25) + (size_t)li * DM * DFF, DFF, DM, DFF, MAP_ID, 0, INP(6) + (size_t)li * DM, (bf16_t*)(WR + W_1), scr, lane, gw, NGW, rot);
            conv_matrix(INP(26) + (size_t)li * DFF * DM, DM, DFF, DM, MAP_ID, 0, nullptr, (bf16_t*)(WR + W_2), scr, lane, gw, NGW, rot);
            if (!(li & 1)) {
                __syncthreads();
                if (li == 0) { for (int ck = vcu; ck < M / 16; ck += G) unorm_chunk<true>(lds, INP(0), hb, T2, ck, tid); }
                else { for (int ck = vcu; ck < M / 16; ck += G) unorm_chunk<false>(lds, nullptr, hb, T2, ck, tid); }
            }
            if (li == 0) {
                for (int l = 0; l < DEPTH; ++l)
                    conv_matrix(INP(21) + (size_t)l * DM * 2048, 2048, DM, 2048, MAP_ID, 0, INP(5) + (size_t)l * DM, (bf16_t*)(BIG + BIG_WKV) + (size_t)l * 2048 * DM, scr, lane, gw, NGW, rot);
                for (int m = gw; m < MROWS; m += NGW) { const float r = row_f32_to_bf16(INP(1) + (size_t)m * DM, memb + (size_t)m * DM, nullptr, lane); if (lane == 0) rstd_mem[m] = r; }
                if (bx == 0) for (int idx = tid; idx < 24 * 129; idx += NWAVES * 64) {
                    const int gh = idx / 129, jk = idx % 129, gi = gh / 8, dil = gi == 0 ? 1 : (gi == 1 ? 4 : 16), rel = (jk - 64) * dil, n = rel < 0 ? -rel : rel;
                    int bucket = rel > 0 ? 16 : 0;
                    if (n < 8) bucket += n; else { int large = 8 + (int)(logf((float)n / 8.0f) / logf(128.0f) * 8.0f); if (large > 15) large = 15; bucket += large; }
                    biasrel[idx] = INP(2)[bucket * 24 + gh] * LOG2E; }
            }
            __syncthreads();
        }
        if ((kind == K_XQ || (kind == K_S5STATE && li == 0))) { PHASE_TID;
            const bool kv = kind != K_XQ;
            const pg8::Gemm g{kv ? (const bf16_t*)(BIG + BIG_WKV) : (const bf16_t*)(WR + W_XQ), kv ? MROWS : M, kv ? 8192 : DM, DM};
            const pg8::ASrcLinear AS{kv ? (const char*)memb : (const char*)hb, DM};
            pg8::StaticOrder S; S.init(g.M, g.N, G, bx);
            const pg8::EpiHeadNorm<1> E{kv ? nullptr : ssq, rstd_mem, kv ? INP(24) : INP(23) + (size_t)li * 256, nullptr, kv ? kvall : T2, kv ? 8192 : DM, kv ? 1 : 0, QSCALE_X, 0};
            pg8::gemm_phase(lds, g, AS, S, E, tid, nullptr, 0, pg8::NoHook(), kv ? nullptr : (const char*)(WR + W_XO), (unsigned)(DM * DM * 2), (unsigned)(bx * (NWAVES * 64) + tid));
            if (!kv) { pg8::Unit u;
                for (int i = 0; S.next(i, u); ++i) att::xattn_unit(lds, T2, kvall, li, u.pm >> 4, u.pn, u.pm & 15, T1, tid); }
        }
        if (kind == K_S5STATE) { PHASE_TID;
            pg8::StaticOrder S; S.init(1024, 16384, G, bx);
            { const pg8::Gemm g{(const bf16_t*)(WR + W_BST), 1024, 16384, 256}; const pg8::ASrcChunk AS{(const char*)T2, 0};
              const pg8::EpiS5State E{(bf16_t*)(BIG + BIG_F)};
              pg8::gemm_phase(lds, g, AS, S, E, tid); }
            { SP_INIT; pg8::Unit u; for (int i = 0; S.next(i, u); ++i) s5_scan_bg(lds, sp, (const bf16_t*)(BIG + BIG_F), (bf16_t*)(BIG + BIG_XB), u.pm, u.pn, tid); }
            asm volatile("s_waitcnt vmcnt(0)" ::: "memory"); __syncthreads();
            { const pg8::Gemm g{(const bf16_t*)(WR + W_BOUT), 1024, 16384, 512}; const pg8::ASrcChunk AS{(const char*)T2, (long)(WS_BIG + BIG_XB) - (long)WS_T2};
              const pg8::EpiS5Out E{T1};
              pg8::gemm_phase(lds, g, AS, S, E, tid); }
        } else if (kind == K_GLU) { PHASE_TID; STAGGER();
            const pg8::Gemm g{(const bf16_t*)(WR + W_GLU), M, 2048, DM}; const pg8::ASrcLinear AS{(const char*)T1, DM};
            pg8::StaticOrder S; S.init(M, 2048, G, bx);
            const pg8::EpiGlu E{hb, ssq};
            pg8::gemm_phase(lds, g, AS, S, E, tid, (const char*)(WR + W_XQ) + (size_t)(bx >> 6) * (256 * DM * 2), DM, pg8::NoHook(), (const char*)(WR + W_XQ), (unsigned)(DM * DM * 2), (unsigned)(bx * (NWAVES * 64) + tid));
        } else if (kind == K_QKV) { PHASE_TID; STAGGER();
            const int gi = (sub - 1) >> 1;
            const pg8::Gemm g{(const bf16_t*)(WR + W_QKV) + (size_t)gi * 3072 * DM, M, 3072, DM}; const pg8::ASrcLinear AS{(const char*)hb, DM};
            pg8::StaticOrder S; S.init(M, 3072, G, bx);
            const pg8::EpiHeadNorm<2> E{ssq, nullptr, INP(18) + (size_t)j * 128, INP(19) + (size_t)j * 128, (bf16_t*)BIG, 3072, 2, QSCALE_DIL, 0};
            { auto hook = [&]() { if (warseam) { XcdBarrier b2 = bar; b2.bar = (unsigned*)(LDP(28) + WS_CTL) + CW_BAR; xcd_wait(b2); } };
              pg8::gemm_phase(lds, g, AS, S, E, tid, nullptr, 0, hook); }
        } else if (kind == K_RES) { PHASE_TID;
            const bf16_t* Bt = sub == 7 ? (const bf16_t*)(WR + W_AO) : (sub == 10 ? (const bf16_t*)(WR + W_XO) : (const bf16_t*)(WR + W_2));
            const int K = sub == 12 ? DFF : DM;
            const pg8::Gemm g{Bt, M, DM, K}; const pg8::ASrcLinear AS{sub == 12 ? (const char*)BIG : (const char*)T1, K};
            pg8::StaticOrder S; S.init(M, DM, G, bx);
            const pg8::EpiRes E{dupdone ? T1 : hb, dupdone ? (float*)T2 : ssq, (li == DEPTH - 1 && sub == 12 && !dupdone) ? out : nullptr};
            pg8::gemm_phase(lds, g, AS, S, E, tid, (sub == 12 || dupdone) ? nullptr : (const char*)(WR + (sub == 7 ? W_XQ : W_1)) + (size_t)(bx >> 6) * (256 * DM * 2), DM, pg8::NoHook(),
                            (sub == 12 || dupdone) ? nullptr : (const char*)(WR + (sub == 7 ? W_XQ : W_1)), sub == 7 ? (unsigned)(DM * DM * 2) : (unsigned)(DM * DFF * 2), (unsigned)(bx * (NWAVES * 64) + tid));
        } else if (kind == K_MLP1) { PHASE_TID; STAGGER();
            const pg8::Gemm g{(const bf16_t*)(WR + W_1), M, DFF, DM}; const pg8::ASrcLinear AS{(const char*)hb, DM};
            pg8::StaticOrder S; S.init(M, DFF, G, bx);
            { const pg8::EpiMlp1 E{ssq, (bf16_t*)BIG};
            pg8::gemm_phase(lds, g, AS, S, E, tid, (const char*)(WR + W_2) + (size_t)(bx >> 6) * (256 * DFF * 2), DFF, pg8::NoHook(), (const char*)(WR + W_2), (unsigned)(DM * DFF * 2), (unsigned)(bx * (NWAVES * 64) + tid)); }
        }
        else if (kind == K_DIL) { PHASE_TID;
            const int gi = (sub - 2) >> 1, ldil = 2 * gi;
            LAS float* btab = (LAS float*)(lds + RING_BYTES);
            for (int u = vcu; u < 512; u += G) { const int x = u & 15, bh = u >> 4, h = bh & 7;
                int tu = tid; asm volatile("" : "+v"(tu));
                if (tu < 192) { const int jk = tu - 32; btab[tu] = (jk >= 0 && jk <= 128) ? biasrel[(gi * 8 + h) * 129 + jk] : -1e30f; }
                att::dil_unit(lds, btab, (const bf16_t*)BIG, gi, ldil, bh >> 3, h, x & ((1 << ldil) - 1), x >> ldil, T1, (float*)(wsb + WS_MISC + 65536), tu); }
        }
#ifdef DUP_KIND
        if (kind == DUP_KIND && (DUP_SUB < 0 || sub == DUP_SUB) && (DUP_LI < 0 || li == DUP_LI) && !dupdone) { dupdone = true; --ph; } else dupdone = false;
#endif
    }
}
#undef out
#undef ssq
#undef rstd_mem
#undef biasrel
#undef hb
#undef kvall
#undef memb
#undef T1
#undef T2
#undef BIG
#undef WR
#undef SP_INIT
#undef PHASE_TID
#undef LDP
#undef INP
extern "C" void kernel_launch(void* const* d_in, const int* in_sizes, int n_in, void* d_out, int out_size, void* d_ws, size_t ws_size, hipStream_t stream) {
    static int grid = 0;
    if (grid == 0) {
        if (n_in != 27 || ws_size < WS_END || in_sizes[0] != M * DM || out_size != M * DM) { fprintf(stderr, "kernel_launch: unexpected n_in %d / ws %zu\n", n_in, ws_size); grid = -1; return; }
        int dev = 0, cus = 0;
        if (hipGetDevice(&dev) != hipSuccess || hipDeviceGetAttribute(&cus, hipDeviceAttributeMultiprocessorCount, dev) != hipSuccess) { grid = -1; return; }
        if (hipFuncSetAttribute((const void*)mk_fwd, hipFuncAttributeMaxDynamicSharedMemorySize, LDS_BYTES) != hipSuccess) { fprintf(stderr, "kernel_launch: hipFuncSetAttribute failed\n"); grid = -1; return; }
        int nb = 0;
        if (hipOccupancyMaxActiveBlocksPerMultiprocessor(&nb, mk_fwd, NWAVES * 64, (size_t)LDS_BYTES) != hipSuccess || nb < 1) { fprintf(stderr, "kernel_launch: occupancy query failed (%d)\n", nb); grid = -1; return; }
        grid = cus;
    }
    if (grid < 0) return;
    float* out = (float*)d_out; unsigned char* ws = (unsigned char*)d_ws;
    Args a{};
    for (int i = 0; i < 27; ++i) a.in[i] = (const float*)d_in[i];
    a.out = out; a.ws = ws;
    auto fast = [&](int lo, int hi) {
        (void)hipMemsetAsync(ws + WS_CTL, 0, 65536, stream);
        a.ph_lo = lo; a.ph_hi = hi;
        hipLaunchKernelGGL(mk_fwd, dim3(grid), dim3(NWAVES * 64), LDS_BYTES, stream, a);
    };

    fast(0, DEPTH * 16);
}
```

```cpp
#include <hip/hip_runtime.h>
#include <cstdint>
#include <cstdio>

typedef unsigned short bf16_t;
typedef unsigned u32x4 __attribute__((ext_vector_type(4)));
typedef unsigned u32x2 __attribute__((ext_vector_type(2)));
typedef float f32x4 __attribute__((ext_vector_type(4)));

constexpr int BATCH = 4, SEQ = 4096, DM = 1024, M = BATCH * SEQ, DEPTH = 4;
constexpr int MEMLEN = 256, MROWS = BATCH * MEMLEN;
constexpr int DFF = 4096;
constexpr float EPS = 1e-6f;
constexpr float LOG2E = 1.4426950408889634f;
constexpr float QSCALE_DIL = 0.08838834764831845f * LOG2E;
constexpr float QSCALE_X = 0.0625f * LOG2E;

constexpr size_t MiB = 1u << 20;
constexpr size_t WS_CTL = 0;
constexpr size_t WS_MISC = 1 * MiB;
constexpr size_t WS_SSQ = 2 * MiB;
constexpr size_t WS_HB = 4 * MiB;
constexpr size_t WS_KV = 36 * MiB;
constexpr size_t WS_MEMB = 52 * MiB;
constexpr size_t WS_T1 = 54 * MiB;
constexpr size_t WS_T2 = 86 * MiB;
constexpr size_t WS_BIG = 118 * MiB;
constexpr size_t WS_W = 246 * MiB;
constexpr size_t WS_END = 342 * MiB;

__device__ __forceinline__ float bf2f(bf16_t v) { return __uint_as_float((unsigned)v << 16); }
__device__ __forceinline__ unsigned f2bf(float f) { unsigned u = __float_as_uint(f); return (u + 0x7fffu + ((u >> 16) & 1u)) >> 16; }
__device__ __forceinline__ unsigned pk2(float lo, float hi) { return f2bf(lo) | (f2bf(hi) << 16); }

namespace pg8 {
#define PG8_LAS __attribute__((address_space(3)))
typedef short bf16x8 __attribute__((ext_vector_type(8)));
constexpr int BM = 256, BK = 64, HALF = 128, HTB = HALF * BK * 2  , STAGE_BYTES = 8 * HTB, NXCD = 8, WGM = 8;
constexpr int XCH_OFF = STAGE_BYTES;

__host__ __device__ __forceinline__ int lds_byte(int r, int c) { const int st = (r >> 4) * 2 + (c >> 5), rr = r & 15, cc = c & 31, ob = rr * 64 + cc * 2; return st * 1024 + (ob ^ (((ob >> 9) & 1) << 5)); }
__host__ __device__ __forceinline__ void stage_rc(int b, int& R, int& C) { const int st = b / 1024, sb = b % 1024, swz = sb ^ (((sb >> 9) & 1) << 5); R = (st >> 1) * 16 + swz / 64; C = (st & 1) * 32 + (swz % 64) / 2; }
__host__ __device__ __forceinline__ int perm32(int rho) { const int n = rho >> 4, i = rho & 15; return 8 * (i >> 2) + 4 * n + (i & 3); }

struct Unit { int pm, pn; };
struct StaticOrder {
    int nM, nN, nwg, G, c;
    __device__ void init(int M_, int N_, int G_, int c_) { nM = M_ / BM; nN = N_ / BM; nwg = nM * nN; G = G_; c = c_; }
    __device__ bool next(int i, Unit& u) const {
        const long L = (long)i * G + c; if (L >= nwg) return false;
        int wgid = (int)L; { const int q = nwg / NXCD, r = nwg % NXCD, xcd = wgid % NXCD, off = wgid / NXCD; wgid = (xcd < r ? xcd * (q + 1) : r * (q + 1) + (xcd - r) * q) + off; }
        const int nig = WGM * nN, gid = wgid / nig, fm = gid * WGM, gsz = (nM - fm) < WGM ? (nM - fm) : WGM;
        u.pm = fm + ((wgid % nig) % gsz); u.pn = (wgid % nig) / gsz; return true;
    }
};

struct ASrcLinear {
    const char* A; int K;
    __device__ __forceinline__ unsigned voff(int R, int C) const { return (unsigned)(R * K + C) * 2u; }
    __device__ __forceinline__ size_t hstep() const { return (size_t)HALF * K * 2; }
    __device__ __forceinline__ const char* tile(const Unit& u, int t) const { return A + (size_t)u.pm * 2 * hstep() + (size_t)t * (BK * 2); }
};
struct ASrcChunk {
    const char* U; long xoff;
    __device__ __forceinline__ unsigned voff(int R, int C) const { return (unsigned)(R * 256 + C) * 2u; }
    __device__ __forceinline__ size_t hstep() const { return (size_t)HALF * 512; }
    __device__ __forceinline__ const char* tile(const Unit& u, int t) const { return U + (long)(t >> 2) * xoff + (size_t)u.pn * (1024 * 512) + (size_t)u.pm * 2 * hstep() + (size_t)(t & 3) * (BK * 2); }
};
struct Gemm { const bf16_t* Bt; int M, N, K; };

__device__ __forceinline__ unsigned cvt_pk_bf16(float lo, float hi) { unsigned r; asm volatile("v_cvt_pk_bf16_f32 %0, %1, %2" : "=v"(r) : "v"(lo), "v"(hi)); return r; }
__device__ __forceinline__ float shx(float v, int lane, int mask) { return __builtin_bit_cast(float, __builtin_amdgcn_ds_bpermute((lane ^ mask) << 2, __builtin_bit_cast(int, v))); }
#define PG8_XBAR() do { asm volatile("s_waitcnt lgkmcnt(0)" ::: "memory"); __builtin_amdgcn_s_barrier(); asm volatile("" ::: "memory"); } while (0)

constexpr int RSTD_OFF = STAGE_BYTES + 8192 + 1024;
__device__ __forceinline__ void rstd_panel_to_lds(PG8_LAS unsigned char* lds, const float* ssq, int pm, int tid) {
    const int row = tid >> 1, hf = tid & 1, lane = tid & 63;
    const f32x4* p = (const f32x4*)(ssq + (size_t)(pm * BM + row) * 32 + hf * 16);
    const f32x4 a = p[0], b = p[1], c = p[2], d = p[3];
    float s = (((a.x + a.y) + (a.z + a.w)) + ((b.x + b.y) + (b.z + b.w))) + (((c.x + c.y) + (c.z + c.w)) + ((d.x + d.y) + (d.z + d.w)));
    s += shx(s, lane, 1);
    if (hf == 0) ((PG8_LAS float*)(lds + RSTD_OFF))[row] = rsqrtf(s * (1.0f / 1024.f) + 1e-6f);
}
__device__ __forceinline__ void rstd_from_lds(PG8_LAS unsigned char* lds, int wr, int fr, float (&rs)[2][4]) {
#pragma unroll
    for (int ai = 0; ai < 2; ++ai)
#pragma unroll
        for (int m = 0; m < 4; ++m) rs[ai][m] = ((const PG8_LAS float*)(lds + RSTD_OFF))[ai * HALF + wr * 64 + m * 16 + fr];
}
typedef f32x4 AccT[2][2][4][2];

__device__ __forceinline__ f32x4 bf_lo4(unsigned a, unsigned b) { return (f32x4){__uint_as_float(a << 16), __uint_as_float(a & 0xffff0000u), __uint_as_float(b << 16), __uint_as_float(b & 0xffff0000u)}; }
struct EpiRes {
    static constexpr bool PERM = true, AFTER_DRAIN = false;
    bf16_t* hb; float* ssq; float* fout;
    __device__ __forceinline__ void prologue(const Unit&, PG8_LAS unsigned char*, int) const {}
    __device__ __forceinline__ void operator()(AccT& acc, const Unit& u, int wr, int wc, int fr, int fq, PG8_LAS unsigned char*) const {
        const int col0 = u.pn * BM + wc * 32 + 8 * fq, lane = fr + 16 * fq;
        const int row0 = u.pm * BM + wr * 64 + fr;
        const unsigned e0 = (unsigned)row0 * 1024u + (unsigned)col0;
        const char* hbc = (const char*)hb;
        u32x4 bs[2][4][2];
#pragma unroll
        for (int ai = 0; ai < 2; ++ai)
#pragma unroll
            for (int m = 0; m < 4; ++m) { const unsigned e = e0 + (unsigned)((ai * HALF + m * 16) * 1024);
                bs[ai][m][0] = *(const u32x4*)(hbc + (e * 2u)); bs[ai][m][1] = *(const u32x4*)(hbc + ((e + HALF) * 2u)); }
#pragma unroll
        for (int ai = 0; ai < 2; ++ai) {
#pragma unroll
            for (int m = 0; m < 4; ++m) { const int row = row0 + ai * HALF + m * 16; const unsigned e = e0 + (unsigned)((ai * HALF + m * 16) * 1024);
#pragma unroll
                for (int bj = 0; bj < 2; ++bj) { const u32x4 bb = bs[ai][m][bj];
                    const f32x4 v0 = acc[ai][bj][m][0] + bf_lo4(bb.x, bb.y), v1 = acc[ai][bj][m][1] + bf_lo4(bb.z, bb.w);
                    u32x4 w; w.x = cvt_pk_bf16(v0.x, v0.y); w.y = cvt_pk_bf16(v0.z, v0.w); w.z = cvt_pk_bf16(v1.x, v1.y); w.w = cvt_pk_bf16(v1.z, v1.w);
                    if (fout) { float* fo = (float*)((char*)fout + (size_t)(e + bj * HALF) * 4u); *(f32x4*)fo = v0; *(f32x4*)(fo + 4) = v1; }
                    else {
                        *(u32x4*)((char*)hb + ((e + bj * HALF) * 2u)) = w;
                        float ss = ((v0.x * v0.x + v0.y * v0.y) + (v0.z * v0.z + v0.w * v0.w)) + ((v1.x * v1.x + v1.y * v1.y) + (v1.z * v1.z + v1.w * v1.w));
                        ss += shx(ss, lane, 16); ss += shx(ss, lane, 32);
                        if (fq == 0) ssq[(size_t)row * 32 + u.pn * 8 + bj * 4 + wc] = ss; } } }
            asm volatile("" ::: "memory"); }
    }
};
struct EpiGlu {
    static constexpr bool PERM = true, AFTER_DRAIN = false;
    bf16_t* hb; float* ssq;
    __device__ __forceinline__ void prologue(const Unit&, PG8_LAS unsigned char*, int) const {}
    __device__ __forceinline__ void operator()(AccT& acc, const Unit& u, int wr, int wc, int fr, int fq, PG8_LAS unsigned char*) const {
        const int col0 = u.pn * HALF + wc * 32 + 8 * fq, lane = fr + 16 * fq;
        u32x4 bs[2][4];
#pragma unroll
        for (int ai = 0; ai < 2; ++ai)
#pragma unroll
            for (int m = 0; m < 4; ++m) bs[ai][m] = *(const u32x4*)(hb + (size_t)(u.pm * BM + ai * HALF + wr * 64 + m * 16 + fr) * 1024 + col0);
#pragma unroll
        for (int ai = 0; ai < 2; ++ai)
#pragma unroll
            for (int m = 0; m < 4; ++m) { const int row = u.pm * BM + ai * HALF + wr * 64 + m * 16 + fr; const size_t off = (size_t)row * 1024 + col0;
                const u32x4 bb = bs[ai][m];
                f32x4 v0 = bf_lo4(bb.x, bb.y), v1 = bf_lo4(bb.z, bb.w);
                const f32x4 a0 = acc[ai][0][m][0], a1 = acc[ai][0][m][1], g0 = acc[ai][1][m][0], g1 = acc[ai][1][m][1];
#pragma unroll
                for (int j = 0; j < 4; ++j) { v0[j] += a0[j] * __builtin_amdgcn_rcpf(1.f + __builtin_amdgcn_exp2f(-1.4426950408889634f * g0[j]));
                                              v1[j] += a1[j] * __builtin_amdgcn_rcpf(1.f + __builtin_amdgcn_exp2f(-1.4426950408889634f * g1[j])); }
                u32x4 w; w.x = cvt_pk_bf16(v0.x, v0.y); w.y = cvt_pk_bf16(v0.z, v0.w); w.z = cvt_pk_bf16(v1.x, v1.y); w.w = cvt_pk_bf16(v1.z, v1.w);
                *(u32x4*)(hb + off) = w;
                float ss = ((v0.x * v0.x + v0.y * v0.y) + (v0.z * v0.z + v0.w * v0.w)) + ((v1.x * v1.x + v1.y * v1.y) + (v1.z * v1.z + v1.w * v1.w));
                ss += shx(ss, lane, 16); ss += shx(ss, lane, 32);
                if (fq == 0) ssq[(size_t)row * 32 + u.pn * 4 + wc] = ss; }
    }
};
struct EpiMlp1 {
    static constexpr bool PERM = true, AFTER_DRAIN = false;
    const float* ssq; bf16_t* out;
    __device__ __forceinline__ void prologue(const Unit& u, PG8_LAS unsigned char* lds, int tid) const { rstd_panel_to_lds(lds, ssq, u.pm, tid); }
    __device__ __forceinline__ void operator()(AccT& acc, const Unit& u, int wr, int wc, int fr, int fq, PG8_LAS unsigned char* lds) const {
        const int rowbase = u.pm * BM + wr * 64 + fr, col0 = u.pn * BM + wc * 32 + 8 * fq;
        float rs[2][4]; rstd_from_lds(lds, wr, fr, rs);
#pragma unroll
        for (int ai = 0; ai < 2; ++ai)
#pragma unroll
            for (int m = 0; m < 4; ++m) { bf16_t* rowp = out + (size_t)(rowbase + ai * HALF + m * 16) * 4096 + col0; const float r = rs[ai][m];
#pragma unroll
                for (int bj = 0; bj < 2; ++bj) { f32x4 v0 = acc[ai][bj][m][0] * r, v1 = acc[ai][bj][m][1] * r;
#pragma unroll
                    for (int j = 0; j < 4; ++j) { v0[j] = fmaxf(v0[j], 0.f); v0[j] *= v0[j]; v1[j] = fmaxf(v1[j], 0.f); v1[j] *= v1[j]; }
                    u32x4 w; w.x = cvt_pk_bf16(v0[0], v0[1]); w.y = cvt_pk_bf16(v0[2], v0[3]); w.z = cvt_pk_bf16(v1[0], v1[1]); w.w = cvt_pk_bf16(v1[2], v1[3]);
                    *(u32x4*)(rowp + bj * HALF) = w; } }
    }
};
template <int NSEG> struct EpiHeadNorm {
    static constexpr bool PERM = true, AFTER_DRAIN = false;
    const float* ssq;
    const float* rowscale;
    const float* gain0; const float* gain1;
    bf16_t* out; int ldc; int mode; float sc0; int pad;
    __device__ __forceinline__ void prologue(const Unit& u, PG8_LAS unsigned char* lds, int tid) const { if (ssq) rstd_panel_to_lds(lds, ssq, u.pm, tid); }
    __device__ __forceinline__ void operator()(AccT& acc, const Unit& u, int wr, int wc, int fr, int fq, PG8_LAS unsigned char* lds) const {
        const int rowbase = u.pm * BM + wr * 64 + fr, col0 = u.pn * BM + wc * 32 + 8 * fq;
        bool normed; const float* g; float psc = 1.f;
        if (mode == 0) { normed = true; g = gain0; psc = sc0; }
        else if (mode == 1) { normed = (u.pn & 7) < 4; g = gain0 + 256 * (u.pn >> 3); }
        else { const int which = u.pn >> 2; normed = which < 2; g = which == 0 ? gain0 : gain1; psc = which == 0 ? sc0 : 1.f; }
        f32x4 gv[2][2];
#pragma unroll
        for (int bj = 0; bj < 2; ++bj)
#pragma unroll
            for (int n = 0; n < 2; ++n) gv[bj][n] = normed ? *(const f32x4*)(g + (NSEG == 1 ? bj * HALF : 0) + wc * 32 + 8 * fq + 4 * n) : (f32x4){1.f, 1.f, 1.f, 1.f};
        float rs[2][4];
        if (ssq) rstd_from_lds(lds, wr, fr, rs);
        else {
#pragma unroll
            for (int ai = 0; ai < 2; ++ai)
#pragma unroll
                for (int m = 0; m < 4; ++m) rs[ai][m] = rowscale[rowbase + ai * HALF + m * 16];
        }
        float rn[2][4][2];
        if (normed) {
            PG8_LAS float* P = (PG8_LAS float*)(lds + XCH_OFF);
#pragma unroll
            for (int ai = 0; ai < 2; ++ai)
#pragma unroll
                for (int m = 0; m < 4; ++m) { float s[2];
#pragma unroll
                    for (int bj = 0; bj < 2; ++bj) { const f32x4 a = acc[ai][bj][m][0], b = acc[ai][bj][m][1];
                        s[bj] = ((a.x * a.x + a.y * a.y) + (a.z * a.z + a.w * a.w)) + ((b.x * b.x + b.y * b.y) + (b.z * b.z + b.w * b.w)); }
                    if (NSEG == 1) { s[0] += s[1]; s[1] = 0.f; }
#pragma unroll
                    for (int sg = 0; sg < NSEG; ++sg) { float t = s[sg]; t += shx(t, fr + 16 * fq, 16); t += shx(t, fr + 16 * fq, 32);
                        if (fq == 0) P[((ai * HALF + wr * 64 + m * 16 + fr) * 2 + sg) * 4 + wc] = t; } }
            PG8_XBAR();
#pragma unroll
            for (int ai = 0; ai < 2; ++ai)
#pragma unroll
                for (int m = 0; m < 4; ++m)
#pragma unroll
                    for (int sg = 0; sg < NSEG; ++sg) { const f32x4 t = *(const PG8_LAS f32x4*)(P + ((ai * HALF + wr * 64 + m * 16 + fr) * 2 + sg) * 4);
                        const float r0 = rs[ai][m]; rn[ai][m][sg] = rsqrtf(((t.x + t.y) + (t.z + t.w)) * (r0 * r0) * (NSEG == 1 ? 1.0f / 256.f : 1.0f / 128.f) + 1e-6f) * (psc * r0); }
        }
#pragma unroll
        for (int ai = 0; ai < 2; ++ai)
#pragma unroll
            for (int m = 0; m < 4; ++m) { bf16_t* rowp = out + (size_t)(rowbase + ai * HALF + m * 16) * ldc + col0;
#pragma unroll
                for (int bj = 0; bj < 2; ++bj) { const float r = normed ? rn[ai][m][NSEG == 1 ? 0 : bj] : rs[ai][m];
                    const f32x4 v0 = acc[ai][bj][m][0] * gv[bj][0] * r, v1 = acc[ai][bj][m][1] * gv[bj][1] * r;
                    u32x4 w; w.x = cvt_pk_bf16(v0[0], v0[1]); w.y = cvt_pk_bf16(v0[2], v0[3]); w.z = cvt_pk_bf16(v1[0], v1[1]); w.w = cvt_pk_bf16(v1[2], v1[3]);
                    *(u32x4*)(rowp + bj * HALF) = w; } }
    }
};
struct EpiS5State {
    static constexpr bool PERM = true, AFTER_DRAIN = false;
    bf16_t* F;
    __device__ __forceinline__ void prologue(const Unit&, PG8_LAS unsigned char*, int) const {}
    __device__ __forceinline__ void operator()(AccT& acc, const Unit& u, int wr, int wc, int fr, int fq, PG8_LAS unsigned char*) const {
        const int col0 = wc * 32 + 8 * fq;
#pragma unroll
        for (int ai = 0; ai < 2; ++ai)
#pragma unroll
            for (int m = 0; m < 4; ++m) { bf16_t* rowp = F + ((size_t)u.pn * 1024 + u.pm * BM + ai * HALF + wr * 64 + m * 16 + fr) * 256 + col0;
#pragma unroll
                for (int bj = 0; bj < 2; ++bj) { const f32x4 v0 = acc[ai][bj][m][0], v1 = acc[ai][bj][m][1];
                    u32x4 w; w.x = cvt_pk_bf16(v0[0], v0[1]); w.y = cvt_pk_bf16(v0[2], v0[3]); w.z = cvt_pk_bf16(v1[0], v1[1]); w.w = cvt_pk_bf16(v1[2], v1[3]);
                    *(u32x4*)(rowp + bj * HALF) = w; } }
    }
};
__device__ __forceinline__ float gelu_tanh_fast(float x) {
    const float z2 = 2.302208198f * (x + 0.044715f * x * x * x);
    const float e = __builtin_amdgcn_exp2f(z2);
    return x - x * __builtin_amdgcn_rcpf(1.f + e);
}
struct EpiS5Out {
    static constexpr bool PERM = true, AFTER_DRAIN = false;
    bf16_t* G;
    __device__ __forceinline__ void prologue(const Unit&, PG8_LAS unsigned char*, int) const {}
    __device__ __forceinline__ void operator()(AccT& acc, const Unit& u, int wr, int wc, int fr, int fq, PG8_LAS unsigned char*) const {
#pragma unroll
        for (int ai = 0; ai < 2; ++ai)
#pragma unroll
            for (int m = 0; m < 4; ++m) { const int crow = u.pm * BM + ai * HALF + wr * 64 + m * 16 + fr;
#pragma unroll
                for (int bj = 0; bj < 2; ++bj) { const int c = bj * HALF + wc * 32 + 8 * fq, s = c >> 4, ch0 = c & 15;
                    f32x4 v0 = acc[ai][bj][m][0], v1 = acc[ai][bj][m][1];
#pragma unroll
                    for (int j = 0; j < 4; ++j) { v0[j] = gelu_tanh_fast(v0[j]); v1[j] = gelu_tanh_fast(v1[j]); }
                    u32x4 w; w.x = cvt_pk_bf16(v0[0], v0[1]); w.y = cvt_pk_bf16(v0[2], v0[3]); w.z = cvt_pk_bf16(v1[0], v1[1]); w.w = cvt_pk_bf16(v1[2], v1[3]);
                    *(u32x4*)(G + ((size_t)crow * 16 + s) * 1024 + u.pn * 16 + ch0) = w; } }
    }
};

struct NoHook { __device__ __forceinline__ void operator()() const {} };
template <class Epi, class ASrc, class Hook = NoHook>
__device__ __forceinline__ void gemm_phase(PG8_LAS unsigned char* lds, const Gemm g, const ASrc AS, const StaticOrder& S, const Epi& E, const int tid  ,
                                           const char* warm = nullptr  , int wK = 0, const Hook& hook = Hook(),
                                           const char* wmat = nullptr  , unsigned wbytes = 0, unsigned gtid = 0  ) {
    const int wid = __builtin_amdgcn_readfirstlane(tid >> 6), lane = tid & 63, wr = wid >> 2, wc = wid & 3, fr = lane & 15, fq = lane >> 4;
    const int K = g.K, nt = K / BK;
    unsigned voffA[2], voffB[2];
#pragma unroll
    for (int i = 0; i < 2; ++i) { int R, C; stage_rc(tid * 16 + i * 8192, R, C); const int Rb = Epi::PERM ? ((R & ~31) + perm32(R & 31)) : R;
        voffA[i] = AS.voff(R, C); voffB[i] = (unsigned)(Rb * K + C) * 2u; }
    const size_t kstep = (size_t)(BK * 2);
    const size_t hstepB = (size_t)HALF * K * 2, hstepA = AS.hstep();
    const unsigned ldsw = (unsigned)wid * 1024u;
    const int aoff = lds_byte(wr * 64 + fr, fq * 8), boff = lds_byte(wc * 32 + fr, fq * 8);
#define PG8_SA(b, h) (((b) * 2 + (h)) * HTB)
#define PG8_SB(b, h) ((4 + (b) * 2 + (h)) * HTB)
#define PG8_STAGE(bufoff, gbase, voff) do { _Pragma("unroll") for (int _i = 0; _i < 2; ++_i) \
        __builtin_amdgcn_global_load_lds((const unsigned*)((const char*)(gbase) + (voff)[_i]), (PG8_LAS unsigned*)(lds + (bufoff) + ldsw + _i * 8192), 16, 0, 0); } while (0)
#define PG8_LDA(dst, b, h) do { _Pragma("unroll") for (int m = 0; m < 4; ++m) _Pragma("unroll") for (int k = 0; k < 2; ++k) dst[m][k] = *(const PG8_LAS bf16x8*)(lds + PG8_SA(b, h) + aoff + m * 2048 + k * 1024); } while (0)
#define PG8_LDB(dst, b, h) do { _Pragma("unroll") for (int n = 0; n < 2; ++n) _Pragma("unroll") for (int k = 0; k < 2; ++k) dst[n][k] = *(const PG8_LAS bf16x8*)(lds + PG8_SB(b, h) + boff + n * 2048 + k * 1024); } while (0)
#define PG8_MMA(ai, bj, At, Bt) do { __builtin_amdgcn_s_setprio(1); _Pragma("unroll") for (int m = 0; m < 4; ++m) _Pragma("unroll") for (int n = 0; n < 2; ++n) _Pragma("unroll") for (int k = 0; k < 2; ++k) \
        acc[ai][bj][m][n] = __builtin_amdgcn_mfma_f32_16x16x32_bf16(Bt[n][k], At[m][k], acc[ai][bj][m][n], 0, 0, 0); __builtin_amdgcn_s_setprio(0); } while (0)
#define PG8_WAIT_V(n) asm volatile("s_waitcnt vmcnt(" #n ")" ::: "memory")
#define PG8_WAIT_L(n) asm volatile("s_waitcnt lgkmcnt(" #n ")" ::: "memory")
#define PG8_BAR __builtin_amdgcn_s_barrier()
#define PG8_SCHED __builtin_amdgcn_sched_barrier(0)
    Unit cur, nxt; int ui = 0; unsigned warmv = 0u, warmm = 0u;
    if (!S.next(0, cur)) return;
    AccT acc;
#pragma unroll
    for (int a = 0; a < 2; ++a)
#pragma unroll
        for (int b = 0; b < 2; ++b)
#pragma unroll
            for (int m = 0; m < 4; ++m)
#pragma unroll
                for (int n = 0; n < 2; ++n) acc[a][b][m][n] = (f32x4){0.f, 0.f, 0.f, 0.f};
    bf16x8 At[4][2], B0[2][2], B1[2][2];
    const char* cB = (const char*)g.Bt + (size_t)cur.pn * 2 * hstepB;
    { const char* cA0 = AS.tile(cur, 0); const char* cA1 = AS.tile(cur, 1);
      PG8_STAGE(PG8_SB(0, 0), cB, voffB); PG8_STAGE(PG8_SB(0, 1), cB + hstepB, voffB); PG8_STAGE(PG8_SA(0, 0), cA0, voffA); PG8_STAGE(PG8_SA(0, 1), cA0 + hstepA, voffA);
      PG8_STAGE(PG8_SB(1, 0), cB + kstep, voffB); PG8_STAGE(PG8_SA(1, 0), cA1, voffA); PG8_STAGE(PG8_SB(1, 1), cB + hstepB + kstep, voffB);
      E.prologue(cur, lds, tid);
      if (wr == 1) PG8_BAR;
      PG8_WAIT_V(8); PG8_BAR;
      PG8_WAIT_V(6); PG8_BAR; }
    for (;;) {
        const bool has_next = S.next(ui + 1, nxt);
        const Unit nu = has_next ? nxt : cur;
        const char* nB = (const char*)g.Bt + (size_t)nu.pn * 2 * hstepB;
#pragma unroll 1
        for (int t = 0; t < nt; t += 2) {
            const bool last = (t == nt - 2);
            const char* a1 = AS.tile(cur, t + 1);
            const char* a2 = last ? AS.tile(nu, 0) : AS.tile(cur, t + 2); const char* b2 = last ? nB : cB + (size_t)(t + 2) * kstep;
            const char* a3 = last ? AS.tile(nu, 1) : AS.tile(cur, t + 3); const char* b3 = b2 + kstep;
            PG8_LDB(B0, 0, 0); PG8_LDB(B1, 0, 1); PG8_SCHED; PG8_LDA(At, 0, 0); PG8_STAGE(PG8_SA(1, 1), a1 + hstepA, voffA);
            PG8_WAIT_V(8); PG8_WAIT_L(0); PG8_BAR; PG8_MMA(0, 0, At, B0); PG8_MMA(0, 1, At, B1); PG8_BAR; PG8_SCHED;
            PG8_LDA(At, 0, 1); PG8_STAGE(PG8_SB(0, 0), b2, voffB); PG8_STAGE(PG8_SB(0, 1), b2 + hstepB, voffB); PG8_STAGE(PG8_SA(0, 0), a2, voffA);
            PG8_WAIT_V(8); PG8_WAIT_L(0); PG8_BAR; PG8_MMA(1, 0, At, B0); PG8_MMA(1, 1, At, B1); PG8_BAR; PG8_SCHED;
            PG8_LDB(B0, 1, 0); PG8_LDB(B1, 1, 1); PG8_SCHED; PG8_LDA(At, 1, 0); PG8_STAGE(PG8_SA(0, 1), a2 + hstepA, voffA);
            PG8_WAIT_V(8); PG8_WAIT_L(0); PG8_BAR; PG8_MMA(0, 0, At, B0); PG8_MMA(0, 1, At, B1); PG8_BAR; PG8_SCHED;
            PG8_LDA(At, 1, 1); PG8_STAGE(PG8_SB(1, 0), b3, voffB); PG8_STAGE(PG8_SB(1, 1), b3 + hstepB, voffB); PG8_STAGE(PG8_SA(1, 0), a3, voffA);
            PG8_WAIT_V(8); PG8_WAIT_L(0); PG8_BAR; PG8_MMA(1, 0, At, B0); PG8_MMA(1, 1, At, B1); PG8_BAR; PG8_SCHED;
        }
        if (wr == 0) PG8_BAR;
        if (!has_next && wmat && gtid * 128u < wbytes) asm volatile("global_load_dword %0, %1, off" : "+v"(warmm) : "v"(wmat + (size_t)gtid * 128u) : "memory");
        if (!has_next && warm) warmv = *(const volatile unsigned*)(warm + ((size_t)(tid & 255) * wK + (size_t)(tid >> 8) * BK) * 2);
        if (ui == 0) hook();
        E(acc, cur, wr, wc, fr, fq, lds);
        if (!has_next) break;
#pragma unroll
        for (int a = 0; a < 2; ++a)
#pragma unroll
            for (int b = 0; b < 2; ++b)
#pragma unroll
                for (int m = 0; m < 4; ++m)
#pragma unroll
                    for (int n = 0; n < 2; ++n) acc[a][b][m][n] = (f32x4){0.f, 0.f, 0.f, 0.f};
        cur = nxt; cB = nB; ++ui;
        if (wr == 1) PG8_BAR;
    }
    PG8_WAIT_V(0);
    asm volatile("" :: "v"(warmv), "v"(warmm));
    PG8_BAR;
#undef PG8_SA
#undef PG8_SB
#undef PG8_STAGE
#undef PG8_LDA
#undef PG8_LDB
#undef PG8_MMA
#undef PG8_WAIT_V
#undef PG8_WAIT_L
#undef PG8_BAR
#undef PG8_SCHED
}
}
constexpr int NWAVES = 8;
constexpr int RING_BYTES = 131072;
constexpr int XCH_BYTES = 8192;
constexpr int MISC_OFF = RING_BYTES + XCH_BYTES;
constexpr int LDS_BYTES = 147456;

constexpr size_t W_XQ = 0, W_XO = 2 * MiB, W_1 = 4 * MiB, W_2 = 12 * MiB, W_MIX = 20 * MiB;
constexpr size_t W_GLU = W_MIX, W_BST = W_MIX + 4 * MiB, W_BOUT = W_MIX + 12 * MiB;
constexpr size_t W_QKV = W_MIX + 28 * MiB, W_AO = W_MIX + 46 * MiB;
constexpr size_t BIG_F = 0, BIG_XB = 64 * MiB, BIG_WKV = 96 * MiB;
constexpr int CW_BAR = 4096;

#define GAS __attribute__((address_space(1)))
#define LAS __attribute__((address_space(3)))
typedef GAS unsigned gu32;
#define RLX_AGENT __ATOMIC_RELAXED, __HIP_MEMORY_SCOPE_AGENT
#define LDS_WAIT() asm volatile("s_waitcnt lgkmcnt(0)" ::: "memory")

__device__ __forceinline__ int tid_here(int wave) { int z = 0; asm volatile("" : "+v"(z)); return wave * 64 + (int)__builtin_amdgcn_mbcnt_hi(~0u, __builtin_amdgcn_mbcnt_lo(~0u, (unsigned)z)); }
#define XB_TMO      128
#define XB_XCNT(j)  (256  + 64 * (j))
#define XB_XSUB(j)  (1280 + 64 * (j))
#define XB_XGEN(j)  (2304 + 64 * (j))
#define XB_TOP      3328
#define XB_TOPGEN   3392
#define XB_NLOCAL   3424
#define XB_XCCID    3456
#define XCD_BAR_WORDS 4096
#define XB_SPIN_CAP (1u << 22)
__device__ __forceinline__ unsigned xb_ld(unsigned* p)              { return __hip_atomic_load(p, __ATOMIC_RELAXED, __HIP_MEMORY_SCOPE_AGENT); }
__device__ __forceinline__ unsigned xb_add(unsigned* p, unsigned v) { return __hip_atomic_fetch_add(p, v, __ATOMIC_RELAXED, __HIP_MEMORY_SCOPE_AGENT); }
__device__ __forceinline__ unsigned xb_xcc_id() { return (unsigned)__builtin_amdgcn_s_getreg((3 << 11) | 20) & 0xFu; }
#define XB_SPIN(cond, bar) do { unsigned _sp = 0; while (cond) { __builtin_amdgcn_s_sleep(1); \
    if ((++_sp & 255u) == 0u) { if (xb_ld(&(bar)[XB_TMO])) break; if (_sp > XB_SPIN_CAP) { atomicAdd(&(bar)[XB_TMO], 1u); break; } } } } while (0)
struct XcdBarrier { unsigned* bar; unsigned x; volatile LAS unsigned* st; int wave; };
__device__ __forceinline__ XcdBarrier xcd_barrier_post(unsigned* bar, volatile LAS unsigned* st) {
    XcdBarrier b; b.bar = bar; b.x = xb_xcc_id(); b.st = st; b.wave = __builtin_amdgcn_readfirstlane((int)threadIdx.x >> 6);
    if (threadIdx.x == 0) { (void)xb_add(&bar[XB_XCNT(b.x)], 1u); __hip_atomic_store(&bar[XB_XCCID + blockIdx.x], b.x + 1u, __ATOMIC_RELAXED, __HIP_MEMORY_SCOPE_AGENT); }
    return b;
}
__device__ __forceinline__ void xcd_barrier_complete(unsigned* bar, unsigned x, unsigned& nloc, unsigned& nx) {
    const unsigned G = gridDim.x * gridDim.y * gridDim.z;
    unsigned sum, cnt, mine, sp = 0u;
    for (;;) {
        sum = 0u; cnt = 0u; mine = 0u;
#pragma unroll
        for (unsigned j = 0; j < 16; ++j) { const unsigned c = xb_ld(&bar[XB_XCNT(j)]); sum += c; cnt += (c > 0u) ? 1u : 0u; mine = (j == x) ? c : mine; }
        if (sum == G) break;
        __builtin_amdgcn_s_sleep(1);
        if ((++sp & 255u) == 0u) { if (xb_ld(&bar[XB_TMO])) break; if (sp > XB_SPIN_CAP) { atomicAdd(&bar[XB_TMO], 1u); break; } }
    }
    nloc = mine > 0u ? mine : 1u; nx = cnt > 0u ? cnt : 1u;
}
__device__ __forceinline__ void xcd_barrier(const XcdBarrier& b) {
    asm volatile("s_waitcnt vmcnt(0)" ::: "memory");
    __syncthreads();
    const int tb_ = tid_here(b.wave);
    if (tb_ == 64) asm volatile("buffer_inv sc1\n\ts_waitcnt vmcnt(0)" ::: "memory");
    if (tb_ == 0) {
        unsigned* bar = b.bar;
        __builtin_amdgcn_s_waitcnt(0);
        unsigned nloc = b.st[0], nx = b.st[1];
        if (nloc == 0u) { xcd_barrier_complete(bar, b.x, nloc, nx); b.st[0] = nloc; b.st[1] = nx; }
        const unsigned old = xb_add(&bar[XB_XSUB(b.x)], 1u);
        const unsigned gen = old / nloc;
        if (old + 1u == (gen + 1u) * nloc) {
            __builtin_amdgcn_fence(__ATOMIC_RELEASE, "agent");
            asm volatile("s_waitcnt vmcnt(0)" ::: "memory");
            const unsigned og = xb_add(&bar[XB_TOP], 1u);
            const unsigned tg = og / nx;
            if (og + 1u != (tg + 1u) * nx) XB_SPIN(xb_ld(&bar[XB_TOP]) < (tg + 1u) * nx, bar);
            (void)xb_add(&bar[XB_XGEN(b.x)], 1u);
        } else {
            XB_SPIN(xb_ld(&bar[XB_TOP]) < (gen + 1u) * nx, bar);
            asm volatile("s_waitcnt vmcnt(0)" ::: "memory");
        }
    }
    __syncthreads();
}

__device__ __forceinline__ void xcd_arrive(const XcdBarrier& b) {
    asm volatile("s_waitcnt vmcnt(0)" ::: "memory");
    __syncthreads();
    if (tid_here(b.wave) == 0) {
        unsigned* bar = b.bar;
        const unsigned nloc = b.st[0], nx = b.st[1];
        const unsigned old = xb_add(&bar[XB_XSUB(b.x)], 1u);
        const unsigned gen = old / nloc; const bool leader = old + 1u == (gen + 1u) * nloc;
        if (leader) { __builtin_amdgcn_fence(__ATOMIC_RELEASE, "agent"); asm volatile("s_waitcnt vmcnt(0)" ::: "memory"); (void)xb_add(&bar[XB_TOP], 1u); }
        b.st[4] = (gen + 1u) * nx; b.st[5] = leader ? 1u : 0u;
    }
}
__device__ __forceinline__ void xcd_wait(const XcdBarrier& b) {
    if (tid_here(b.wave) == 0) {
        unsigned* bar = b.bar; const unsigned want = b.st[4];
        XB_SPIN(xb_ld(&bar[XB_TOP]) < want, bar);
        if (b.st[5]) (void)xb_add(&bar[XB_XGEN(b.x)], 1u);
    }
    __syncthreads();
}
constexpr int CW_TEAM = 8192;
__device__ __forceinline__ void team_barrier_local(unsigned* ctl, int team, unsigned target, int wave) {
    asm volatile("s_waitcnt vmcnt(0)" ::: "memory");
    __syncthreads();
    const int tb_ = tid_here(wave);
    if (tb_ == 64) asm volatile("buffer_inv sc1\n\ts_waitcnt vmcnt(0)" ::: "memory");
    if (tb_ == 0) {
        unsigned* ctr = ctl + CW_TEAM + team * 16; unsigned* bar = ctl + CW_BAR;
        const unsigned old_ = xb_add(ctr, 1u);
        if (old_ + 1u < target) XB_SPIN(xb_ld(ctr) < target, bar);
    }
    __syncthreads();
}

__device__ __forceinline__ void conv_item(const float* W, int ldw, int K, int c0, int k0, const float* gain, bf16_t* Wt, int n0, LAS float* scr, int lane) {
    f32x4 v[16];
    const int kr = lane >> 4, n4 = (lane & 15) * 4;
    const float* src = W + (size_t)(k0 + kr) * ldw + c0 + n4;
#pragma unroll
    for (int i = 0; i < 16; ++i) v[i] = __builtin_nontemporal_load((const f32x4*)(src + (size_t)(4 * i) * ldw));
    if (gain) {
#pragma unroll
        for (int i = 0; i < 16; ++i) v[i] = v[i] * gain[k0 + 4 * i + kr];
    }
#pragma unroll
    for (int i = 0; i < 16; ++i) { const int k = 4 * i + kr; *(LAS f32x4*)(scr + k * 64 + (n4 ^ (((k >> 3) & 7) << 2))) = v[i]; }
    LDS_WAIT(); asm volatile("" ::: "memory");
    const int c = lane & 7;
#pragma unroll
    for (int j = 0; j < 8; ++j) { const int n = (lane >> 3) + 8 * j; const LAS float* s = scr + (8 * c) * 64 + (n ^ (c << 2));
        u32x4 o; o.x = pg8::cvt_pk_bf16(s[0 * 64], s[1 * 64]); o.y = pg8::cvt_pk_bf16(s[2 * 64], s[3 * 64]); o.z = pg8::cvt_pk_bf16(s[4 * 64], s[5 * 64]); o.w = pg8::cvt_pk_bf16(s[6 * 64], s[7 * 64]);
        *(u32x4*)(Wt + (size_t)(n0 + n) * K + k0 + 8 * c) = o; }
    LDS_WAIT(); asm volatile("" ::: "memory");
}
enum { MAP_ID = 0, MAP_GLU = 1, MAP_QKV = 2 };
__device__ __forceinline__ int map_col(int kind, int arg, int n0) {
    if (kind == MAP_GLU) { const int pn = n0 >> 8, w = n0 & 255; return (w >> 7) * 1024 + pn * 128 + (w & 127); }
    if (kind == MAP_QKV) { return ((n0 >> 10) * 3 + arg) * 1024 + (n0 & 1023); }
    return n0;
}
__device__ __forceinline__ void conv_matrix(const float* W, int ldw, int K, int N, int kind, int arg, const float* gain, bf16_t* Wt, LAS float* scr, int lane, int gw, int NGW, int& rot) {
    const int nblk = N / 64, nitems = (K / 64) * nblk;
    for (int it = (gw + NGW - rot) % NGW; it < nitems; it += NGW) { const int kb = it / nblk, nb = it % nblk; conv_item(W, ldw, K, map_col(kind, arg, nb * 64), kb * 64, gain, Wt, nb * 64, scr, lane); }
    rot = (rot + nitems) % NGW;
}
__device__ __forceinline__ float wsum_l(float v, int lane) {
#pragma unroll
    for (int o = 1; o < 64; o <<= 1) v += pg8::shx(v, lane, o);
    return v;
}
__device__ __forceinline__ float row_f32_to_bf16(const float* xrow, bf16_t* oraw, bf16_t* onorm, int lane) {
    const f32x4* xr = (const f32x4*)xrow + lane;
    f32x4 v[4]; float s = 0.f;
#pragma unroll
    for (int j = 0; j < 4; ++j) { v[j] = xr[64 * j]; s += (v[j].x * v[j].x + v[j].y * v[j].y) + (v[j].z * v[j].z + v[j].w * v[j].w); }
    const float rstd = rsqrtf(wsum_l(s, lane) * (1.0f / DM) + EPS);
    if (oraw) { u32x2* o = (u32x2*)oraw + lane;
#pragma unroll
        for (int j = 0; j < 4; ++j) { u32x2 w; w.x = pk2(v[j].x, v[j].y); w.y = pk2(v[j].z, v[j].w); o[64 * j] = w; } }
    if (onorm) { u32x2* o = (u32x2*)onorm + lane;
#pragma unroll
        for (int j = 0; j < 4; ++j) { u32x2 w; w.x = pk2(v[j].x * rstd, v[j].y * rstd); w.y = pk2(v[j].z * rstd, v[j].w * rstd); o[64 * j] = w; } }
    return rstd;
}
template <bool F32SRC> __device__ __forceinline__ void unorm_chunk(LAS unsigned char* lds, const float* xsrc, bf16_t* hbio, bf16_t* Ug, int chunk, const int tid) {
    const int lane = tid & 63, wid = __builtin_amdgcn_readfirstlane(tid >> 6);
    LAS unsigned char* T = lds;
#pragma unroll
    for (int rr = 0; rr < 2; ++rr) { const int s = 2 * wid + rr; const size_t row = (size_t)chunk * 16 + s;
        if (F32SRC) { const f32x4* xr = (const f32x4*)(xsrc + row * DM) + lane; f32x4 v[4]; float ss = 0.f;
#pragma unroll
            for (int j = 0; j < 4; ++j) { v[j] = __builtin_nontemporal_load(xr + 64 * j); ss += (v[j].x * v[j].x + v[j].y * v[j].y) + (v[j].z * v[j].z + v[j].w * v[j].w); }
            const float rstd = rsqrtf(wsum_l(ss, lane) * (1.0f / DM) + EPS);
            u32x2* o = (u32x2*)(hbio + row * DM) + lane;
#pragma unroll
            for (int j = 0; j < 4; ++j) { u32x2 w; w.x = pg8::cvt_pk_bf16(v[j].x, v[j].y); w.y = pg8::cvt_pk_bf16(v[j].z, v[j].w); o[64 * j] = w;
                u32x2 q; q.x = pg8::cvt_pk_bf16(v[j].x * rstd, v[j].y * rstd); q.y = pg8::cvt_pk_bf16(v[j].z * rstd, v[j].w * rstd); *(LAS u32x2*)(T + s * 2080 + (64 * j + lane) * 8) = q; }
        } else { const u32x4* xr = (const u32x4*)(hbio + row * DM) + lane; u32x4 w[2]; float v[16]; float ss = 0.f;
#pragma unroll
            for (int j = 0; j < 2; ++j) { w[j] = xr[64 * j];
                v[8 * j + 0] = __uint_as_float(w[j].x << 16); v[8 * j + 1] = __uint_as_float(w[j].x & 0xffff0000u); v[8 * j + 2] = __uint_as_float(w[j].y << 16); v[8 * j + 3] = __uint_as_float(w[j].y & 0xffff0000u);
                v[8 * j + 4] = __uint_as_float(w[j].z << 16); v[8 * j + 5] = __uint_as_float(w[j].z & 0xffff0000u); v[8 * j + 6] = __uint_as_float(w[j].w << 16); v[8 * j + 7] = __uint_as_float(w[j].w & 0xffff0000u); }
#pragma unroll
            for (int i = 0; i < 16; ++i) ss += v[i] * v[i];
            const float rstd = rsqrtf(wsum_l(ss, lane) * (1.0f / DM) + EPS);
#pragma unroll
            for (int j = 0; j < 2; ++j) { u32x4 q; q.x = pg8::cvt_pk_bf16(v[8 * j] * rstd, v[8 * j + 1] * rstd); q.y = pg8::cvt_pk_bf16(v[8 * j + 2] * rstd, v[8 * j + 3] * rstd);
                q.z = pg8::cvt_pk_bf16(v[8 * j + 4] * rstd, v[8 * j + 5] * rstd); q.w = pg8::cvt_pk_bf16(v[8 * j + 6] * rstd, v[8 * j + 7] * rstd); *(LAS u32x4*)(T + s * 2080 + (64 * j + lane) * 16) = q; } }
    }
    LDS_WAIT(); __syncthreads();
#pragma unroll
    for (int i = 0; i < 4; ++i) { const int gq = 8 * wid + 2 * i + (lane >> 5), l = lane & 31, s = l >> 1, hf = l & 1;
        const u32x4 q = *(const LAS u32x4*)(T + s * 2080 + gq * 32 + hf * 16);
        *(u32x4*)(Ug + ((size_t)gq * 1024 + chunk) * 256 + l * 8) = q; }
    LDS_WAIT(); __syncthreads();
}

struct S5In { const float *lam_re, *lam_im, *log_dt, *b_re, *b_im, *c_re, *c_im, *dskip, *gain; };
typedef float f32x2v __attribute__((ext_vector_type(2)));
__device__ __forceinline__ void s5_gen(LAS unsigned char* lds, const S5In P, int g, int q, bf16_t* Bst, bf16_t* Bout, const int tid) {
    LAS f32x2v* pw = (LAS f32x2v*)lds;
    LAS f32x2v* bb = (LAS f32x2v*)(lds + 17408);
    LAS f32x2v* cc = (LAS f32x2v*)(lds + 33792);
    LAS float* kt = (LAS float*)(lds + 50176);
    if (tid < 128) {
        const int di = tid >> 6, p = tid & 63, gp = (di * 64 + g) * 64 + p;
        const float dt = __builtin_amdgcn_exp2f(P.log_dt[di * 64 + g] * 1.4426950408889634f);
        const float lr = P.lam_re[gp], li = P.lam_im[gp];
        const float mag = __builtin_amdgcn_exp2f(lr * dt * 1.4426950408889634f), frv = __builtin_amdgcn_fractf(li * dt * 0.15915494309189535f);
        const float ar = mag * __builtin_amdgcn_cosf(frv), ai = mag * __builtin_amdgcn_sinf(frv);
        const float nr = ar - 1.0f, ni = ai, den = lr * lr + li * li;
        const float fr = (nr * lr + ni * li) / den, fi = (ni * lr - nr * li) / den;
        float wr = 1.0f, wi = 0.0f;
        for (int k = 0; k <= 16; ++k) { pw[(di * 64 + p) * 17 + k] = (f32x2v){wr, wi}; const float t = wr * ar - wi * ai; wi = wr * ai + wi * ar; wr = t; }
        for (int c = 0; c < 16; ++c) { const float br = P.b_re[(size_t)gp * 16 + c], bi = P.b_im[(size_t)gp * 16 + c];
            bb[(di * 64 + p) * 16 + c] = (f32x2v){fr * br - fi * bi, fr * bi + fi * br}; }
    }
    for (int e = tid; e < 2048; e += 512) { const int di = e >> 10, c = (e >> 6) & 15, p = e & 63; const size_t o = ((size_t)(di * 64 + g) * 16 + c) * 64 + p; cc[e] = (f32x2v){P.c_re[o], P.c_im[o]}; }
    __syncthreads();
    { const int di = tid >> 8, k = (tid >> 4) & 15, chb = (tid >> 2) & 3, c2b = tid & 3;
      float acc[4][4];
#pragma unroll
      for (int a_ = 0; a_ < 4; ++a_)
#pragma unroll
          for (int b_ = 0; b_ < 4; ++b_) acc[a_][b_] = 0.f;
      for (int p = 0; p < 64; ++p) { const f32x2v w = pw[(di * 64 + p) * 17 + k]; float zr[4], zi[4];
#pragma unroll
          for (int b_ = 0; b_ < 4; ++b_) { const f32x2v b = bb[(di * 64 + p) * 16 + 4 * c2b + b_]; zr[b_] = w.x * b.x - w.y * b.y; zi[b_] = w.x * b.y + w.y * b.x; }
#pragma unroll
          for (int a_ = 0; a_ < 4; ++a_) { const f32x2v C = cc[(di * 16 + 4 * chb + a_) * 64 + p];
#pragma unroll
              for (int b_ = 0; b_ < 4; ++b_) acc[a_][b_] += C.x * zr[b_] - C.y * zi[b_]; } }
#pragma unroll
      for (int a_ = 0; a_ < 4; ++a_)
#pragma unroll
          for (int b_ = 0; b_ < 4; ++b_) kt[((di * 16 + k) * 16 + 4 * chb + a_) * 16 + 4 * c2b + b_] = acc[a_][b_]; }
    __syncthreads();
    { const int di = q >> 1, ri = q & 1;
      for (int cid = tid; cid < 2048; cid += 512) { const int nl = cid >> 5, k0 = (cid & 31) * 8, r = k0 >> 4, ch0 = k0 & 15;
        const f32x2v w = pw[(di * 64 + nl) * 17 + (di == 0 ? 15 - r : r)]; float v[8];
#pragma unroll
        for (int j = 0; j < 8; ++j) { const f32x2v b = bb[(di * 64 + nl) * 16 + ch0 + j]; const float zr = w.x * b.x - w.y * b.y, zi = w.x * b.y + w.y * b.x; v[j] = (ri == 0 ? zr : zi) * P.gain[g * 16 + ch0 + j]; }
        u32x4 o; o.x = pk2(v[0], v[1]); o.y = pk2(v[2], v[3]); o.z = pk2(v[4], v[5]); o.w = pk2(v[6], v[7]);
        *(u32x4*)(Bst + ((size_t)g * 256 + q * 64 + nl) * 256 + k0) = o; } }
    for (int cid = tid; cid < 4096; cid += 512) { const int nl = cid >> 6, k0 = (cid & 63) * 8, n = q * 64 + nl, s = n >> 4, ch = n & 15; float v[8];
        if (k0 < 256) { const int r = k0 >> 4, c0 = k0 & 15;
#pragma unroll
            for (int j = 0; j < 8; ++j) { const int c2 = c0 + j; float t = 0.f;
                if (r <= s) t += kt[((0 * 16 + (s - r)) * 16 + ch) * 16 + c2];
                if (r >= s) t += kt[((1 * 16 + (r - s)) * 16 + ch) * 16 + c2];
                if (r == s && c2 == ch) t += P.dskip[g * 16 + ch];
                v[j] = t * P.gain[g * 16 + c2]; }
        } else { const int kk = k0 - 256, di = kk >> 7, ri = (kk >> 6) & 1, p0 = kk & 63;
#pragma unroll
            for (int j = 0; j < 8; ++j) { const int p = p0 + j; const f32x2v C = cc[(di * 16 + ch) * 64 + p], w = pw[(di * 64 + p) * 17 + (di == 0 ? s + 1 : 16 - s)];
                v[j] = ri == 0 ? (C.x * w.x - C.y * w.y) : -(C.x * w.y + C.y * w.x); } }
        u32x4 o; o.x = pk2(v[0], v[1]); o.y = pk2(v[2], v[3]); o.z = pk2(v[4], v[5]); o.w = pk2(v[6], v[7]);
        *(u32x4*)(Bout + ((size_t)g * 256 + n) * 512 + k0) = o; }
    __syncthreads();
}

__device__ __forceinline__ void s5_scan_bg(LAS unsigned char* lds, const S5In P, const bf16_t* F, bf16_t* XB, int b, int g, const int tid) {
    const int lane = tid & 63, wid = __builtin_amdgcn_readfirstlane(tid >> 6), p = lane;
    LAS f32x2v* E = (LAS f32x2v*)lds;
    LAS f32x2v* XI = (LAS f32x2v*)(lds + 16384);
    float a1r[2], a1i[2], a16r[2], a16i[2];
#pragma unroll
    for (int di = 0; di < 2; ++di) { const int gp = (di * 64 + g) * 64 + p;
        const float dt = expf(P.log_dt[di * 64 + g]); const float lr = P.lam_re[gp], li = P.lam_im[gp];
        const float mag = expf(lr * dt), ang = li * dt; float ar = mag * cosf(ang), ai = mag * sinf(ang);
#pragma unroll
        for (int sq = 0; sq < 4; ++sq) { const float t = ar * ar - ai * ai; ai = 2.f * ar * ai; ar = t; }
        a1r[di] = ar; a1i[di] = ai;
#pragma unroll
        for (int sq = 0; sq < 4; ++sq) { const float t = ar * ar - ai * ai; ai = 2.f * ar * ai; ar = t; }
        a16r[di] = ar; a16i[di] = ai; }
    const bf16_t* Fb = F + ((size_t)g * 1024 + b * 256) * 256;
    float fr[4][16], fi[4][16];
#pragma unroll
    for (int jj = 0; jj < 4; ++jj) { const int job = wid + 8 * jj, di = job >> 4, seg = job & 15;
#pragma unroll
        for (int j = 0; j < 16; ++j) { const int c = di == 0 ? seg * 16 + j : 255 - (seg * 16 + j); const bf16_t* fp = Fb + (size_t)c * 256 + di * 128 + p; fr[jj][j] = bf2f(fp[0]); fi[jj][j] = bf2f(fp[64]); } }
#pragma unroll
    for (int jj = 0; jj < 4; ++jj) { const int job = wid + 8 * jj, di = job >> 4, seg = job & 15;
        const float ar = di ? a1r[1] : a1r[0], ai = di ? a1i[1] : a1i[0]; float xr = 0.f, xi = 0.f;
#pragma unroll
        for (int j = 0; j < 16; ++j) { const float nxr = ar * xr - ai * xi + fr[jj][j], nxi = ar * xi + ai * xr + fi[jj][j]; xr = nxr; xi = nxi; }
        E[(di * 16 + seg) * 64 + p] = (f32x2v){xr, xi}; }
    LDS_WAIT(); __syncthreads();
    if (tid < 128) { const int di = tid >> 6; const float ar = di ? a16r[1] : a16r[0], ai = di ? a16i[1] : a16i[0]; float xr = 0.f, xi = 0.f;
        for (int seg = 0; seg < 16; ++seg) { XI[(di * 16 + seg) * 64 + p] = (f32x2v){xr, xi}; const f32x2v e = E[(di * 16 + seg) * 64 + p];
            const float nxr = ar * xr - ai * xi + e.x, nxi = ar * xi + ai * xr + e.y; xr = nxr; xi = nxi; } }
    LDS_WAIT(); __syncthreads();
#pragma unroll
    for (int jj = 0; jj < 4; ++jj) { const int job = wid + 8 * jj, di = job >> 4, seg = job & 15;
        const float ar = di ? a1r[1] : a1r[0], ai = di ? a1i[1] : a1i[0]; const f32x2v x0 = XI[(di * 16 + seg) * 64 + p]; float xr = x0.x, xi = x0.y;
        bf16_t* xg = XB + ((size_t)g * 1024 + b * 256) * 256 + di * 128 + p;
#pragma unroll
        for (int j = 0; j < 16; ++j) { const int c = di == 0 ? seg * 16 + j : 255 - (seg * 16 + j);
            xg[(size_t)c * 256] = (bf16_t)f2bf(xr); xg[(size_t)c * 256 + 64] = (bf16_t)f2bf(xi);
            const float nxr = ar * xr - ai * xi + fr[jj][j], nxi = ar * xi + ai * xr + fi[jj][j]; xr = nxr; xi = nxi; } }
    __syncthreads();
}
namespace att {
typedef float f32x16 __attribute__((ext_vector_type(16)));
typedef short bf16x8 __attribute__((ext_vector_type(8)));
typedef short v4i16_t __attribute__((ext_vector_type(4)));
typedef LAS const char* lds_cptr;
__device__ __forceinline__ v4i16_t vtr(lds_cptr p) { return __builtin_amdgcn_ds_read_tr16_b64_v4i16((LAS v4i16_t*)p); }
__device__ __forceinline__ void glds16(const void* gsrc, LAS unsigned char* dst_uniform) { __builtin_amdgcn_global_load_lds((const unsigned*)gsrc, (LAS unsigned*)dst_uniform, 16, 0, 0); }
__device__ __forceinline__ unsigned pkbf(float lo, float hi) { return pg8::cvt_pk_bf16(lo, hi); }
__device__ __forceinline__ bf16x8 pack8(const f32x16& p, int base) {
    u32x4 w; w.x = pkbf(p[base + 0], p[base + 1]); w.y = pkbf(p[base + 2], p[base + 3]); w.z = pkbf(p[base + 4], p[base + 5]); w.w = pkbf(p[base + 6], p[base + 7]);
    return __builtin_bit_cast(bf16x8, w);
}
#define ATT_SYNC() do { asm volatile("s_waitcnt vmcnt(0) lgkmcnt(0)" ::: "memory"); __syncthreads(); } while (0)

template <bool MERGE> __device__ __forceinline__ void store_ot(const f32x16& acc, float sc, bf16_t* rowp  , int hi, float wa, float wb, const u32x4 (&oldv)[2]) {
    unsigned w[8];
#pragma unroll
    for (int g = 0; g < 4; ++g) { w[2 * g] = pkbf(acc[4 * g] * sc, acc[4 * g + 1] * sc); w[2 * g + 1] = pkbf(acc[4 * g + 2] * sc, acc[4 * g + 3] * sc); }
#pragma unroll
    for (int g = 0; g < 4; g += 2) {
        const auto rx = __builtin_amdgcn_permlane32_swap(w[2 * g], w[2 * g + 2], false, false);
        const auto ry = __builtin_amdgcn_permlane32_swap(w[2 * g + 1], w[2 * g + 3], false, false);
        u32x4 o; o.x = rx[0]; o.y = ry[0]; o.z = rx[1]; o.w = ry[1];
        u32x4* dst = (u32x4*)(rowp + 8 * g + (hi ? 8 : 0));
        if (MERGE) { const u32x4 old = oldv[g >> 1];
#define ATT_MRG(N, O) pkbf(__uint_as_float((O) << 16) * wa + __uint_as_float((N) << 16) * wb, __uint_as_float((O) & 0xffff0000u) * wa + __uint_as_float((N) & 0xffff0000u) * wb)
            o.x = ATT_MRG(o.x, old.x); o.y = ATT_MRG(o.y, old.y); o.z = ATT_MRG(o.z, old.z); o.w = ATT_MRG(o.w, old.w);
#undef ATT_MRG
        }
        *dst = o;
    }
}

__device__ __forceinline__ void xattn_unit(LAS unsigned char* lds, const bf16_t* Qx, const bf16_t* KV, int li, int b, int h, int qb, bf16_t* XO, const int tid) {
    const int lane = tid & 63, wid = __builtin_amdgcn_readfirstlane(tid >> 6), r32 = lane & 31, hi = lane >> 5;
    const size_t tok = (size_t)b * SEQ + qb * 256 + wid * 32 + r32;
    const bf16_t* Kb = KV + (size_t)b * MEMLEN * 8192 + li * 2048 + h * 256;
#pragma unroll 4
    for (int ii = 0; ii < 16; ++ii) { const int i = wid * 16 + ii, key = 2 * i + hi, c = r32 ^ (key & 15);
        glds16(Kb + (size_t)key * 8192 + c * 8, lds + i * 1024); }
    bf16x8 qf[16]; { const bf16_t* qp = Qx + tok * 1024 + h * 256 + hi * 8;
#pragma unroll
        for (int s = 0; s < 16; ++s) qf[s] = *(const bf16x8*)(qp + 16 * s); }
    ATT_SYNC();
    f32x16 S[8];
#pragma unroll
    for (int kt = 0; kt < 8; ++kt) { f32x16 acc = {}; const lds_cptr kp = (lds_cptr)lds + (32 * kt + r32) * 512;
#pragma unroll
        for (int s = 0; s < 16; ++s) { const bf16x8 kf = *(const LAS bf16x8*)(kp + (((2 * s + hi) ^ (r32 & 15)) << 4)); acc = __builtin_amdgcn_mfma_f32_32x32x16_bf16(kf, qf[s], acc, 0, 0, 0); }
        S[kt] = acc; }
    float m = S[0][0];
#pragma unroll
    for (int kt = 0; kt < 8; ++kt)
#pragma unroll
        for (int r = 0; r < 16; ++r) m = fmaxf(m, S[kt][r]);
    m = fmaxf(m, pg8::shx(m, lane, 32));
    float l = 0.f;
#pragma unroll
    for (int kt = 0; kt < 8; ++kt)
#pragma unroll
        for (int r = 0; r < 16; ++r) { const float p = __builtin_amdgcn_exp2f(S[kt][r] - m); S[kt][r] = p; l += p; }
    l += pg8::shx(l, lane, 32);
    const float inv = __builtin_amdgcn_rcpf(l);
    bf16x8 pf[16];
#pragma unroll
    for (int kt = 0; kt < 8; ++kt) { pf[2 * kt] = pack8(S[kt], 0); pf[2 * kt + 1] = pack8(S[kt], 8); }
    ATT_SYNC();
    const bf16_t* Vb = Kb + 1024;
#pragma unroll 4
    for (int ii = 0; ii < 16; ++ii) { const int i = wid * 16 + ii, d0 = i >> 4, ks = i & 15, key = 16 * ks + 8 * hi + ((lane >> 2) & 7), cc = lane & 3;
        glds16(Vb + (size_t)key * 8192 + 32 * d0 + 8 * cc, lds + i * 1024); }
    ATT_SYNC();
    const lds_cptr vb = (lds_cptr)lds + ((lane >> 4) & 1) * 32 + (lane & 3) * 8 + (4 * hi + ((lane & 15) >> 2)) * 64;
    bf16_t* orow = XO + tok * 1024 + h * 256;
#pragma unroll 1
    for (int d0 = 0; d0 < 8; ++d0) { f32x16 acc = {};
#pragma unroll
        for (int ks = 0; ks < 16; ++ks) { const v4i16_t lo = vtr(vb + d0 * 16384 + ks * 1024), hh = vtr(vb + d0 * 16384 + ks * 1024 + 512);
            const bf16x8 vf = {lo[0], lo[1], lo[2], lo[3], hh[0], hh[1], hh[2], hh[3]};
            acc = __builtin_amdgcn_mfma_f32_32x32x16_bf16(vf, pf[ks], acc, 0, 0, 0); }
        const u32x4 none[2] = {}; store_ot<false>(acc, inv, orow + 32 * d0, hi, 0.f, 0.f, none); }
    ATT_SYNC();
}

__device__ __forceinline__ void dil_unit(LAS unsigned char* lds, const LAS float* btab, const bf16_t* QKV, int gi, int ldil, int b, int h, int r, int ub, bf16_t* AO, float* lseacc, const int tid) {
    const int lane = tid & 63, wid = __builtin_amdgcn_readfirstlane(tid >> 6), r32 = lane & 31, hi = lane >> 5;
    const int sub_len = SEQ >> ldil, k0 = ub * 256 - 64;
    const size_t tokb = (size_t)b * SEQ + r;
    const bf16_t* base = QKV + h * 128;
#pragma unroll 4
    for (int ii = 0; ii < 12; ++ii) { const int i = wid * 12 + ii, kk = 4 * i + (lane >> 4), c = (lane & 15) ^ (kk & 15); int ki = k0 + kk; ki = ki < 0 ? 0 : (ki >= sub_len ? sub_len - 1 : ki);
        glds16(base + (tokb + ((size_t)ki << ldil)) * 3072 + 1024 + c * 8, lds + i * 1024); }
    const int qi = ub * 256 + wid * 32 + r32; const size_t qtok = tokb + ((size_t)qi << ldil);
    bf16x8 qf[8]; { const bf16_t* qp = base + qtok * 3072 + hi * 8;
#pragma unroll
        for (int s = 0; s < 8; ++s) qf[s] = *(const bf16x8*)(qp + 16 * s); }
    ATT_SYNC();
    f32x16 S[5];
    int r15 = r32 & 15; asm volatile("" : "+v"(r15));
#pragma unroll
    for (int t = 0; t < 5; ++t) { f32x16 acc = {}; const lds_cptr kp = (lds_cptr)lds + (32 * wid + 32 * t + r32) * 256;
#pragma unroll
        for (int s = 0; s < 8; ++s) { const bf16x8 kf = *(const LAS bf16x8*)(kp + (((2 * s + hi) ^ r15) << 4)); acc = __builtin_amdgcn_mfma_f32_32x32x16_bf16(kf, qf[s], acc, 0, 0, 0); }
        S[t] = acc; }
    ATT_SYNC();
#pragma unroll 1
    for (int ii = 0; ii < 12; ++ii) { const int i = wid * 12 + ii, d0 = i / 24, ks = i % 24, kk = 16 * ks + 8 * hi + ((lane >> 2) & 7), cc = lane & 3; int ki = k0 + kk; ki = ki < 0 ? 0 : (ki >= sub_len ? sub_len - 1 : ki);
        glds16(base + (tokb + ((size_t)ki << ldil)) * 3072 + 2048 + 32 * d0 + 8 * cc, lds + i * 1024); }
    float m = -3.0e38f;
#pragma unroll
    for (int t = 0; t < 5; ++t)
#pragma unroll
        for (int rr = 0; rr < 16; ++rr) { const int cr = (rr & 3) + 8 * (rr >> 2) + 4 * hi, jk = 32 * t + cr - r32, ki = k0 + 32 * wid + 32 * t + cr;
            float s = S[t][rr] + btab[jk + 32];
            s = ((unsigned)ki < (unsigned)sub_len) ? s : -1e30f;
            S[t][rr] = s; m = fmaxf(m, s); }
    m = fmaxf(m, pg8::shx(m, lane, 32));
    float l = 0.f;
#pragma unroll
    for (int t = 0; t < 5; ++t)
#pragma unroll
        for (int rr = 0; rr < 16; ++rr) { const float p = __builtin_amdgcn_exp2f(S[t][rr] - m); S[t][rr] = p; l += p; }
    l += pg8::shx(l, lane, 32);
    const float inv = __builtin_amdgcn_rcpf(l), lse = m + __builtin_amdgcn_logf(l);
    bf16x8 pf[10];
#pragma unroll
    for (int t = 0; t < 5; ++t) { pf[2 * t] = pack8(S[t], 0); pf[2 * t + 1] = pack8(S[t], 8); }
    bf16_t* orow = AO + qtok * 1024 + h * 128;
    u32x4 oldv[4][2] = {};
    if (gi > 0) {
#pragma unroll
        for (int d0 = 0; d0 < 4; ++d0)
#pragma unroll
            for (int g2 = 0; g2 < 2; ++g2) oldv[d0][g2] = *(const u32x4*)(orow + 32 * d0 + 16 * g2 + (hi ? 8 : 0)); }
    float wa = 0.f, wb = 1.f, ln = lse;
    float* lp = lseacc + qtok * 8 + h;
    if (gi > 0) { const float la = *lp, mx = fmaxf(la, lse); ln = mx + __builtin_amdgcn_logf(__builtin_amdgcn_exp2f(la - mx) + __builtin_amdgcn_exp2f(lse - mx)); wa = __builtin_amdgcn_exp2f(la - ln); wb = __builtin_amdgcn_exp2f(lse - ln); }
    ATT_SYNC();
    const lds_cptr vb = (lds_cptr)lds + ((lane >> 4) & 1) * 32 + (lane & 3) * 8 + (4 * hi + ((lane & 15) >> 2)) * 64 + 2 * wid * 1024;
#pragma unroll
    for (int d0 = 0; d0 < 4; ++d0) { f32x16 acc = {};
#pragma unroll
        for (int k = 0; k < 10; ++k) { const v4i16_t lo = vtr(vb + (d0 * 24 + k) * 1024), hh = vtr(vb + (d0 * 24 + k) * 1024 + 512);
            const bf16x8 vf = {lo[0], lo[1], lo[2], lo[3], hh[0], hh[1], hh[2], hh[3]};
            acc = __builtin_amdgcn_mfma_f32_32x32x16_bf16(vf, pf[k], acc, 0, 0, 0); }
        if (gi > 0) store_ot<true>(acc, inv, orow + 32 * d0, hi, wa, wb, oldv[d0]); else store_ot<false>(acc, inv, orow + 32 * d0, hi, 0.f, 0.f, oldv[d0]); }
    if (hi == 0) *lp = ln;
    ATT_SYNC();
}
#undef ATT_SYNC
}
struct Args { const float* in[27]; float* out; unsigned char* ws; int ph_lo, ph_hi; };
static_assert(sizeof(Args) == 27 * 8 + 8 + 8 + 8, "Args must have no padding");
enum { K_NONE = 0, K_PREP, K_S5STATE, K_SCAN, K_S5OUT, K_GLU, K_KV, K_QKV, K_DIL, K_RES, K_XQ, K_XATTN, K_MLP1 };
__host__ __device__ __forceinline__ int phase_kind(int li, int sub) {
    const bool odd = li & 1;
    switch (sub) {
        case 0: return K_PREP;
        case 1: return odd ? K_QKV : K_S5STATE;
        case 2: return odd ? K_DIL : K_NONE;
        case 3: return odd ? K_QKV : K_NONE;
        case 4: return odd ? K_DIL : K_GLU;
        case 5: return odd ? K_QKV : K_NONE;
        case 6: return odd ? K_DIL : K_NONE;
        case 7: return odd ? K_RES : K_NONE;
        case 8: return K_XQ;
        case 9: return K_NONE;
        case 10: return K_RES;
        case 11: return K_MLP1;
        case 12: return K_RES;
        default: return K_NONE;
    }
}

__global__ void __launch_bounds__(NWAVES * 64, 2) mk_fwd(Args a) {
    extern __shared__ __attribute__((aligned(16))) unsigned char lds_raw[];
    LAS unsigned char* lds = (LAS unsigned char*)lds_raw;
    const int tid0 = threadIdx.x, wave0 = __builtin_amdgcn_readfirstlane(tid0 >> 6);
    const int G = gridDim.x, bx = blockIdx.x, vcu = (G % 8 == 0) ? (bx % 8) * (G / 8) + bx / 8 : bx, NGW = G * NWAVES;
    volatile LAS unsigned* MISC = (volatile LAS unsigned*)(lds + MISC_OFF);
    for (int u = tid0; u < 64; u += NWAVES * 64) MISC[u] = 0u;
    __syncthreads();
    volatile LAS unsigned long long* LP = (volatile LAS unsigned long long*)(lds + MISC_OFF + 256);
    if (tid0 == 0) {
#pragma unroll
        for (int i = 0; i < 27; ++i) LP[i] = (unsigned long long)a.in[i];
        LP[27] = (unsigned long long)a.out; LP[28] = (unsigned long long)a.ws;
    }
    __syncthreads();
#define LDP(i) ((unsigned char*)(GAS unsigned char*)(((unsigned long long)(unsigned)__builtin_amdgcn_readfirstlane((int)(LPv[i] >> 32)) << 32) | (unsigned long long)(unsigned)__builtin_amdgcn_readfirstlane((int)(unsigned)LPv[i])))
#define INP(i) ((const float*)LDP(i))
    XcdBarrier bar = xcd_barrier_post((unsigned*)(a.ws + WS_CTL) + CW_BAR, MISC + 8);
#define out ((float*)LDP(27))
#define ssq ((float*)(wsb + WS_SSQ))
#define rstd_mem ((float*)(wsb + WS_MISC))
#define biasrel ((float*)(wsb + WS_MISC + 16384))
#define hb ((bf16_t*)(wsb + WS_HB))
#define kvall ((bf16_t*)(wsb + WS_KV))
#define memb ((bf16_t*)(wsb + WS_MEMB))
#define T1 ((bf16_t*)(wsb + WS_T1))
#define T2 ((bf16_t*)(wsb + WS_T2))
#define BIG (wsb + WS_BIG)
#define WR (wsb + WS_W)

#ifndef STAG_TICKS
#define STAG_TICKS 0
#endif
#define STAGGER() do { if (STAG_TICKS) { const unsigned long long t0_ = __builtin_amdgcn_s_memrealtime(); const unsigned long long dl_ = (unsigned long long)(vcu >> 6) * STAG_TICKS; while (__builtin_amdgcn_s_memrealtime() - t0_ < dl_) __builtin_amdgcn_s_sleep(1); } } while (0)
    bool first = true;
#ifndef SPLIT_WAR_SEAMS
#define SPLIT_WAR_SEAMS 1
#endif
#ifndef TEAM_LOCAL_SEAMS
#define TEAM_LOCAL_SEAMS 1
#endif
#ifdef DUP_KIND
    bool dupdone = false;
#else
    const bool dupdone = false;
#endif
    for (int ph = a.ph_lo; ph < a.ph_hi; ++ph) {
        const int li = ph >> 4, sub = ph & 15, j = li >> 1, kind = phase_kind(li, sub);
        if (kind == K_NONE) continue;
        unsigned lpo = MISC_OFF + 256; asm volatile("" : "+v"(lpo));
        volatile LAS unsigned long long* LPv = (volatile LAS unsigned long long*)(lds + lpo);
#ifndef REP_GRID
#define REP_GRID 1
#endif
        const bool teamseam = TEAM_LOCAL_SEAMS && G == 256 && !dupdone && (sub == 8 || sub == 10 || sub == 11 || sub == 12) && MISC[8 + 2] != 0u;
        const bool warseam = SPLIT_WAR_SEAMS && G == 256 && !dupdone && kind == K_QKV && sub != 1;
#ifndef SPLIT_PREP_SEAMS
#define SPLIT_PREP_SEAMS 1
#endif
        const bool prepseam = SPLIT_PREP_SEAMS && G == 256 && !dupdone && kind == K_PREP && li > 0;
        const bool qkv0seam = SPLIT_PREP_SEAMS && G == 256 && !dupdone && (kind == K_QKV || kind == K_S5STATE) && sub == 1 && li > 0;
        if (!first && qkv0seam) { XcdBarrier b2 = bar; b2.bar = (unsigned*)(LDP(28) + WS_CTL) + CW_BAR; if (tid_here(wave0) == 64) asm volatile("buffer_inv sc1\n\ts_waitcnt vmcnt(0)" ::: "memory");
            xcd_wait(b2); }
        else if (!first && (warseam || prepseam)) { XcdBarrier b2 = bar; b2.bar = (unsigned*)(LDP(28) + WS_CTL) + CW_BAR; xcd_arrive(b2); }
        else if (!first && teamseam) { const unsigned tbk = 4u * (unsigned)li + (sub == 8 ? 1u : (sub == 10 ? 2u : (sub == 11 ? 3u : 4u)));
            team_barrier_local((unsigned*)(LDP(28) + WS_CTL), 8 * (bx & 7) + ((bx >> 3) & 7), 4u * tbk, wave0); }
        else if (!first) { for (int rp = 0; rp < REP_GRID; ++rp) { XcdBarrier b2 = bar; b2.bar = (unsigned*)(LDP(28) + WS_CTL) + CW_BAR; xcd_barrier(b2); }
            if (G == 256 && li == 0 && sub == 1 && tid_here(wave0) == 0) { unsigned* bw = (unsigned*)(LDP(28) + WS_CTL) + CW_BAR; const unsigned me = xb_ld(&bw[XB_XCCID + bx]); bool loc = true;
                for (int q = 0; q < 4; ++q) loc = loc && (xb_ld(&bw[XB_XCCID + (bx & 63) + 64 * q]) == me);
                if (loc) (void)xb_add(&bw[XB_NLOCAL], 1u); }
            if (G == 256 && li == 0 && sub == 4) { if (tid_here(wave0) == 0) { unsigned* bw = (unsigned*)(LDP(28) + WS_CTL) + CW_BAR; MISC[8 + 2] = (xb_ld(&bw[XB_NLOCAL]) == (unsigned)G) ? 1u : 0u; } __syncthreads(); }
        }
        first = false;
        unsigned char* const wsb = LDP(28);
#define PHASE_TID int zero_ = 0; asm volatile("" : "+v"(zero_)); const int tid = wave0 * 64 + (int)__builtin_amdgcn_mbcnt_hi(~0u, __builtin_amdgcn_mbcnt_lo(~0u, (unsigned)zero_)); \
        const int lane = tid & 63, wave = wave0, gw = vcu * NWAVES + wave0; (void)lane; (void)wave; (void)gw
#define SP_INIT const S5In sp{INP(7) + (size_t)j * 8192, INP(8) + (size_t)j * 8192, INP(9) + (size_t)j * 128, INP(10) + (size_t)j * 131072, INP(11) + (size_t)j * 131072, \
                      INP(12) + (size_t)j * 131072, INP(13) + (size_t)j * 131072, INP(14) + (size_t)j * DM, INP(3) + (size_t)li * DM}
        if (kind == K_PREP) { PHASE_TID;
            LAS float* scr = (LAS float*)(lds + wave * 16384);
            int rot = 0;
            if (!(li & 1)) { SP_INIT; for (int it = bx; it < 256; it += G) s5_gen(lds, sp, it >> 2, it & 3, (bf16_t*)(WR + W_BST), (bf16_t*)(WR + W_BOUT), tid);
                conv_matrix(INP(15) + (size_t)j * DM * 2048, 2048, DM, 2048, MAP_GLU, 0, nullptr, (bf16_t*)(WR + W_GLU), scr, lane, gw, NGW, rot);
            } else {
                conv_matrix(INP(17) + (size_t)j * DM * DM, DM, DM, DM, MAP_ID, 0, nullptr, (bf16_t*)(WR + W_AO), scr, lane, gw, NGW, rot);
                for (int gi = 2; gi >= 0; --gi)
                    conv_matrix(INP(16) + (size_t)j * DM * 9216, 9216, DM, 3072, MAP_QKV, gi, INP(3) + (size_t)li * DM, (bf16_t*)(WR + W_QKV) + (size_t)gi * 3072 * DM, scr, lane, gw, NGW, rot);
            }
            if (prepseam) { XcdBarrier b2 = bar; b2.bar = (unsigned*)(LDP(28) + WS_CTL) + CW_BAR; __syncthreads();
                if (tid == 64) asm volatile("buffer_inv sc1\n\ts_waitcnt vmcnt(0)" ::: "memory");
                xcd_wait(b2);
            }
            if (!(li & 1)) {
                __syncthreads();
                if (li == 0) { for (int ck = vcu; ck < M / 16; ck += G) unorm_chunk<true>(lds, INP(0), hb, T2, ck, tid); }
                else { for (int ck = vcu; ck < M / 16; ck += G) unorm_chunk<false>(lds, nullptr, hb, T2, ck, tid); }
            }
            if (prepseam) { XcdBarrier b3 = bar; b3.bar = (unsigned*)(LDP(28) + WS_CTL) + CW_BAR; xcd_arrive(b3); }
            conv_matrix(INP(20) + (size_t)li * DM * DM, DM, DM, DM, MAP_ID, 0, INP(4) + (size_t)li * DM, (bf16_t*)(WR + W_XQ), scr, lane, gw, NGW, rot);
            conv_matrix(INP(22) + (size_t)li * DM * DM, DM, DM, DM, MAP_ID, 0, nullptr, (bf16_t*)(WR + W_XO), scr, lane, gw, NGW, rot);
            conv_matrix(INP(25) + (size_t)li * DM * DFF, DFF, DM, DFF, MAP_ID, 0, INP(6) + (size_t)li * DM, (bf16_t*)(WR + W_1), scr, lane, gw, NGW, rot);
            conv_matrix(INP(26) + (size_t)li * DFF * DM, DM, DFF, DM, MAP_ID, 0, nullptr, (bf16_t*)(WR + W_2), scr, lane, gw, NGW, rot);
            if (li == 0) {
                for (int l = 0; l < DEPTH; ++l)
                    conv_matrix(INP(21) + (size_t)l * DM * 2048, 2048, DM, 2048, MAP_ID, 0, INP(5) + (size_t)l * DM, (bf16_t*)(BIG + BIG_WKV) + (size_t)l * 2048 * DM, scr, lane, gw, NGW, rot);
                for (int m = gw; m < MROWS; m += NGW) { const float r = row_f32_to_bf16(INP(1) + (size_t)m * DM, memb + (size_t)m * DM, nullptr, lane); if (lane == 0) rstd_mem[m] = r; }
                if (bx == 0) for (int idx = tid; idx < 24 * 129; idx += NWAVES * 64) {
                    const int gh = idx / 129, jk = idx % 129, gi = gh / 8, dil = gi == 0 ? 1 : (gi == 1 ? 4 : 16), rel = (jk - 64) * dil, n = rel < 0 ? -rel : rel;
                    int bucket = rel > 0 ? 16 : 0;
                    if (n < 8) bucket += n; else { int large = 8 + (int)(logf((float)n / 8.0f) / logf(128.0f) * 8.0f); if (large > 15) large = 15; bucket += large; }
                    biasrel[idx] = INP(2)[bucket * 24 + gh] * LOG2E; }
            }
            __syncthreads();
        }
        if ((kind == K_XQ || (kind == K_S5STATE && li == 0))) { PHASE_TID;
            const bool kv = kind != K_XQ;
            const pg8::Gemm g{kv ? (const bf16_t*)(BIG + BIG_WKV) : (const bf16_t*)(WR + W_XQ), kv ? MROWS : M, kv ? 8192 : DM, DM};
            const pg8::ASrcLinear AS{kv ? (const char*)memb : (const char*)hb, DM};
            pg8::StaticOrder S; S.init(g.M, g.N, G, bx);
            const pg8::EpiHeadNorm<1> E{kv ? nullptr : ssq, rstd_mem, kv ? INP(24) : INP(23) + (size_t)li * 256, nullptr, kv ? kvall : T2, kv ? 8192 : DM, kv ? 1 : 0, QSCALE_X, 0};
            pg8::gemm_phase(lds, g, AS, S, E, tid, nullptr, 0, pg8::NoHook(), kv ? nullptr : (const char*)(WR + W_XO), (unsigned)(DM * DM * 2), (unsigned)(bx * (NWAVES * 64) + tid));
            if (!kv) { pg8::Unit u;
                for (int i = 0; S.next(i, u); ++i) att::xattn_unit(lds, T2, kvall, li, u.pm >> 4, u.pn, u.pm & 15, T1, tid); }
        }
        if (kind == K_S5STATE) { PHASE_TID;
            pg8::StaticOrder S; S.init(1024, 16384, G, bx);
            { const pg8::Gemm g{(const bf16_t*)(WR + W_BST), 1024, 16384, 256}; const pg8::ASrcChunk AS{(const char*)T2, 0};
              const pg8::EpiS5State E{(bf16_t*)(BIG + BIG_F)};
              pg8::gemm_phase(lds, g, AS, S, E, tid); }
            { SP_INIT; pg8::Unit u; for (int i = 0; S.next(i, u); ++i) s5_scan_bg(lds, sp, (const bf16_t*)(BIG + BIG_F), (bf16_t*)(BIG + BIG_XB), u.pm, u.pn, tid); }
            asm volatile("s_waitcnt vmcnt(0)" ::: "memory"); __syncthreads();
            { const pg8::Gemm g{(const bf16_t*)(WR + W_BOUT), 1024, 16384, 512}; const pg8::ASrcChunk AS{(const char*)T2, (long)(WS_BIG + BIG_XB) - (long)WS_T2};
              const pg8::EpiS5Out E{T1};
              pg8::gemm_phase(lds, g, AS, S, E, tid); }
        } else if (kind == K_GLU) { PHASE_TID; STAGGER();
            const pg8::Gemm g{(const bf16_t*)(WR + W_GLU), M, 2048, DM}; const pg8::ASrcLinear AS{(const char*)T1, DM};
            pg8::StaticOrder S; S.init(M, 2048, G, bx);
            const pg8::EpiGlu E{hb, ssq};
            pg8::gemm_phase(lds, g, AS, S, E, tid, (const char*)(WR + W_XQ) + (size_t)(bx >> 6) * (256 * DM * 2), DM, pg8::NoHook(), (const char*)(WR + W_XQ), (unsigned)(DM * DM * 2), (unsigned)(bx * (NWAVES * 64) + tid));
        } else if (kind == K_QKV) { PHASE_TID; STAGGER();
            const int gi = (sub - 1) >> 1;
            const pg8::Gemm g{(const bf16_t*)(WR + W_QKV) + (size_t)gi * 3072 * DM, M, 3072, DM}; const pg8::ASrcLinear AS{(const char*)hb, DM};
            pg8::StaticOrder S; S.init(M, 3072, G, bx);
            const pg8::EpiHeadNorm<2> E{ssq, nullptr, INP(18) + (size_t)j * 128, INP(19) + (size_t)j * 128, (bf16_t*)BIG, 3072, 2, QSCALE_DIL, 0};
            { auto hook = [&]() { if (warseam) { XcdBarrier b2 = bar; b2.bar = (unsigned*)(LDP(28) + WS_CTL) + CW_BAR; xcd_wait(b2); } };
              pg8::gemm_phase(lds, g, AS, S, E, tid, nullptr, 0, hook); }
        } else if (kind == K_RES) { PHASE_TID;
            const bf16_t* Bt = sub == 7 ? (const bf16_t*)(WR + W_AO) : (sub == 10 ? (const bf16_t*)(WR + W_XO) : (const bf16_t*)(WR + W_2));
            const int K = sub == 12 ? DFF : DM;
            const pg8::Gemm g{Bt, M, DM, K}; const pg8::ASrcLinear AS{sub == 12 ? (const char*)BIG : (const char*)T1, K};
            pg8::StaticOrder S; S.init(M, DM, G, bx);
            const pg8::EpiRes E{dupdone ? T1 : hb, dupdone ? (float*)T2 : ssq, (li == DEPTH - 1 && sub == 12 && !dupdone) ? out : nullptr};
            pg8::gemm_phase(lds, g, AS, S, E, tid, (sub == 12 || dupdone) ? nullptr : (const char*)(WR + (sub == 7 ? W_XQ : W_1)) + (size_t)(bx >> 6) * (256 * DM * 2), DM, pg8::NoHook(),
                            (sub == 12 || dupdone) ? nullptr : (const char*)(WR + (sub == 7 ? W_XQ : W_1)), sub == 7 ? (unsigned)(DM * DM * 2) : (unsigned)(DM * DFF * 2), (unsigned)(bx * (NWAVES * 64) + tid));
        } else if (kind == K_MLP1) { PHASE_TID; STAGGER();
            const pg8::Gemm g{(const bf16_t*)(WR + W_1), M, DFF, DM}; const pg8::ASrcLinear AS{(const char*)hb, DM};
            pg8::StaticOrder S; S.init(M, DFF, G, bx);
            { const pg8::EpiMlp1 E{ssq, (bf16_t*)BIG};
            pg8::gemm_phase(lds, g, AS, S, E, tid, (const char*)(WR + W_2) + (size_t)(bx >> 6) * (256 * DFF * 2), DFF, pg8::NoHook(), (const char*)(WR + W_2), (unsigned)(DM * DFF * 2), (unsigned)(bx * (NWAVES * 64) + tid)); }
        }
        else if (kind == K_DIL) { PHASE_TID;
            const int gi = (sub - 2) >> 1, ldil = 2 * gi;
            LAS float* btab = (LAS float*)(lds + RING_BYTES);
            for (int u = vcu; u < 512; u += G) { const int x = u & 15, bh = u >> 4, h = bh & 7;
                int tu = tid; asm volatile("" : "+v"(tu));
                if (tu < 192) { const int jk = tu - 32; btab[tu] = (jk >= 0 && jk <= 128) ? biasrel[(gi * 8 + h) * 129 + jk] : -1e30f; }
                att::dil_unit(lds, btab, (const bf16_t*)BIG, gi, ldil, bh >> 3, h, x & ((1 << ldil) - 1), x >> ldil, T1, (float*)(wsb + WS_MISC + 65536), tu); }
        }
#ifdef DUP_KIND
        if (kind == DUP_KIND && (DUP_SUB < 0 || sub == DUP_SUB) && (DUP_LI < 0 || li == DUP_LI) && !dupdone) { dupdone = true; --ph; } else dupdone = false;
#endif
    }
}
#undef out
#undef ssq
#undef rstd_mem
#undef biasrel
#undef hb
#undef kvall
#undef memb
#undef T1
#undef T2
#undef BIG
#undef WR
#undef SP_INIT
#undef PHASE_TID
#undef LDP
#undef INP
extern "C" void kernel_launch(void* const* d_in, const int* in_sizes, int n_in, void* d_out, int out_size, void* d_ws, size_t ws_size, hipStream_t stream) {
    static int grid = 0;
    if (grid == 0) {
        if (n_in != 27 || ws_size < WS_END || in_sizes[0] != M * DM || out_size != M * DM) { fprintf(stderr, "kernel_launch: unexpected n_in %d / ws %zu\n", n_in, ws_size); grid = -1; return; }
        int dev = 0, cus = 0;
        if (hipGetDevice(&dev) != hipSuccess || hipDeviceGetAttribute(&cus, hipDeviceAttributeMultiprocessorCount, dev) != hipSuccess) { grid = -1; return; }
        if (hipFuncSetAttribute((const void*)mk_fwd, hipFuncAttributeMaxDynamicSharedMemorySize, LDS_BYTES) != hipSuccess) { fprintf(stderr, "kernel_launch: hipFuncSetAttribute failed\n"); grid = -1; return; }
        int nb = 0;
        if (hipOccupancyMaxActiveBlocksPerMultiprocessor(&nb, mk_fwd, NWAVES * 64, (size_t)LDS_BYTES) != hipSuccess || nb < 1) { fprintf(stderr, "kernel_launch: occupancy query failed (%d)\n", nb); grid = -1; return; }
        grid = cus;
    }
    if (grid < 0) return;
    float* out = (float*)d_out; unsigned char* ws = (unsigned char*)d_ws;
    Args a{};
    for (int i = 0; i < 27; ++i) a.in[i] = (const float*)d_in[i];
    a.out = out; a.ws = ws;
    auto fast = [&](int lo, int hi) {
        (void)hipMemsetAsync(ws + WS_CTL, 0, 65536, stream);
        a.ph_lo = lo; a.ph_hi = hi;
        hipLaunchKernelGGL(mk_fwd, dim3(grid), dim3(NWAVES * 64), LDS_BYTES, stream, a);
    };

    fast(0, DEPTH * 16);
}
```
